# Optimizing an MI355X kernel written in HIP

```python
import math
import jax, jax.numpy as jnp
from jax import lax
import numpy as np

D_MODEL = 1024
BATCH = 16
SEQ = 4096
DEPTH = 2

N_META = 16
N_A_LAYERS = DEPTH // 2
N_B_LAYERS = DEPTH - N_A_LAYERS
D_FF = 2816
SSM_WIDTH = D_MODEL // 2
SSM_GROUP = 16
SSM_GROUPS = SSM_WIDTH // SSM_GROUP
SSM_STATE = 64
STEP_MIN = 1e-3
STEP_MAX = 1e-1
HEAD_DIM = 64
N_Q_HEADS = D_MODEL // HEAD_DIM
N_KV_HEADS = 4
Q_PER_KV = N_Q_HEADS // N_KV_HEADS
WINDOW = 128
BLOCK = 128
ROPE_THETA = 10000.0
EPS = 1e-6
NEG_INF = -1e30

kernel_name = "yoco_s5_swa_sink_macaron"


def rms_norm(x, g):
    xf = x.astype(jnp.float32)
    y = xf * lax.rsqrt(jnp.mean(xf * xf, axis=-1, keepdims=True) + EPS)
    return (y * g.astype(jnp.float32)).astype(x.dtype)


def rope(x, pos):
    half = HEAD_DIM // 2
    freqs = ROPE_THETA ** (-jnp.arange(0, half, dtype=jnp.float32) * 2.0 / HEAD_DIM)
    ang = pos.astype(jnp.float32)[:, None] * freqs[None, :]
    bshape = (pos.shape[0],) + (1,) * (x.ndim - 3) + (half,)
    cos = jnp.cos(ang).reshape(bshape)
    sin = jnp.sin(ang).reshape(bshape)
    xf = x.astype(jnp.float32)
    x1, x2 = xf[..., :half], xf[..., half:]
    return jnp.concatenate([x1 * cos - x2 * sin, x2 * cos + x1 * sin], axis=-1).astype(x.dtype)


def swiglu_ffn(h, g, w_gate_up, w_down):
    a, b = jnp.split(rms_norm(h, g) @ w_gate_up, 2, axis=-1)
    return (jax.nn.silu(a) * b) @ w_down


def _complex_scan_op(e1, e2):
    a1r, a1i, b1r, b1i = e1
    a2r, a2i, b2r, b2i = e2
    return (a2r * a1r - a2i * a1i,
            a2r * a1i + a2i * a1r,
            a2r * b1r - a2i * b1i + b2r,
            a2r * b1i + a2i * b1r + b2i)


def s5_mixer(hn, w_in, lam_re, lam_im, b_re, b_im, c_re, c_im, log_step, d_skip, w_out):
    bsz, L, _ = hn.shape
    f = lambda t: t.astype(jnp.float32)
    u = f(hn @ w_in)
    ug = u.reshape(bsz, L, SSM_GROUPS, SSM_GROUP)
    lr, li = f(lam_re), f(lam_im)
    step = jnp.exp(f(log_step))[:, None]
    mag = jnp.exp(lr * step)
    ar = mag * jnp.cos(li * step)
    ai = mag * jnp.sin(li * step)
    den = lr * lr + li * li
    nr, ni = ar - 1.0, ai
    cr = (nr * lr + ni * li) / den
    ci = (ni * lr - nr * li) / den
    br, bi = f(b_re), f(b_im)
    bbar_r = cr[..., None] * br - ci[..., None] * bi
    bbar_i = cr[..., None] * bi + ci[..., None] * br
    bu_r = jnp.einsum('blgc,gpc->blgp', ug, bbar_r)
    bu_i = jnp.einsum('blgc,gpc->blgp', ug, bbar_i)
    a_r = jnp.broadcast_to(ar, (1, L, SSM_GROUPS, SSM_STATE))
    a_i = jnp.broadcast_to(ai, (1, L, SSM_GROUPS, SSM_STATE))
    _, _, xr, xi = lax.associative_scan(_complex_scan_op, (a_r, a_i, bu_r, bu_i), axis=1)
    y = jnp.einsum('blgp,gcp->blgc', xr, f(c_re)) - jnp.einsum('blgp,gcp->blgc', xi, f(c_im))
    y = y.reshape(bsz, L, SSM_WIDTH) + f(d_skip) * u
    z = jax.nn.gelu(y).astype(hn.dtype) @ w_out
    a, g = jnp.split(z, 2, axis=-1)
    return a * jax.nn.sigmoid(g)


def shared_kv(h, g_kv, w_kv, k_gain):
    bsz, L, _ = h.shape
    k, v = jnp.split(rms_norm(h, g_kv) @ w_kv, 2, axis=-1)
    k = k.reshape(bsz, L, N_KV_HEADS, HEAD_DIM)
    v = v.reshape(bsz, L, N_KV_HEADS, HEAD_DIM)
    k = rope(rms_norm(k, k_gain), jnp.arange(L))
    return k, v


def swa_sink_attention(hn, k, v, w_q, q_gain, sinks, w_o):
    bsz, S, _ = hn.shape
    nb = S // BLOCK
    q = (hn @ w_q).reshape(bsz, S, N_KV_HEADS, Q_PER_KV, HEAD_DIM)
    q = rope(rms_norm(q, q_gain), N_META + jnp.arange(S))
    qb = q.reshape(bsz, nb, BLOCK, N_KV_HEADS, Q_PER_KV, HEAD_DIM)
    k_meta, v_meta = k[:, :N_META], v[:, :N_META]
    k_blk = k[:, N_META:].reshape(bsz, nb, BLOCK, N_KV_HEADS, HEAD_DIM)
    v_blk = v[:, N_META:].reshape(bsz, nb, BLOCK, N_KV_HEADS, HEAD_DIM)
    pad = ((0, 0), (1, 0), (0, 0), (0, 0), (0, 0))
    k_band = jnp.concatenate([jnp.pad(k_blk, pad)[:, :-1], k_blk], axis=2)
    v_band = jnp.concatenate([jnp.pad(v_blk, pad)[:, :-1], v_blk], axis=2)
    scale = HEAD_DIM ** -0.5
    s_band = jnp.einsum('bnqhgd,bnkhd->bnhgqk', qb, k_band,
                        preferred_element_type=jnp.float32) * scale
    qi = jnp.arange(BLOCK)[:, None]
    kj = jnp.arange(2 * BLOCK)[None, :]
    rel = qi + BLOCK - kj
    blk = jnp.arange(nb)[:, None, None]
    valid = (rel >= 0) & (rel < WINDOW) & ((blk > 0) | (kj >= BLOCK))
    s_band = jnp.where(valid[None, :, None, None], s_band, NEG_INF)
    s_meta = jnp.einsum('bnqhgd,bmhd->bnhgqm', qb, k_meta,
                        preferred_element_type=jnp.float32) * scale
    sink = sinks.astype(jnp.float32).reshape(N_KV_HEADS, Q_PER_KV)[None, None, :, :, None]
    m = jnp.maximum(jnp.maximum(s_band.max(-1), s_meta.max(-1)), sink)
    p_band = jnp.exp(s_band - m[..., None])
    p_meta = jnp.exp(s_meta - m[..., None])
    denom = p_band.sum(-1) + p_meta.sum(-1) + jnp.exp(sink - m)
    o = (jnp.einsum('bnhgqk,bnkhd->bnqhgd', p_band, v_band.astype(jnp.float32))
         + jnp.einsum('bnhgqm,bmhd->bnqhgd', p_meta, v_meta.astype(jnp.float32)))
    o = o / jnp.moveaxis(denom, -1, 2)[..., None]
    return o.reshape(bsz, S, N_Q_HEADS * HEAD_DIM).astype(hn.dtype) @ w_o


def setup_inputs(seed: int = 0) -> dict:
    key = jax.random.key(seed)
    ks = jax.random.split(key, 32)
    f32 = jnp.float32

    def nrm(k, shape, scale):
        return jax.random.normal(k, shape, f32) * scale

    H, G, P, C = SSM_WIDTH, SSM_GROUPS, SSM_STATE, SSM_GROUP
    return {
        "x": nrm(ks[0], (BATCH, SEQ, D_MODEL), 1.0),
        "meta_tokens": nrm(ks[1], (N_META, D_MODEL), 1.0),
        "ffn1_norm": 1.0 + nrm(ks[2], (DEPTH, D_MODEL), 0.02),
        "ffn1_w_gate_up": nrm(ks[3], (DEPTH, D_MODEL, 2 * D_FF), D_MODEL ** -0.5),
        "ffn1_w_down": nrm(ks[4], (DEPTH, D_FF, D_MODEL), D_FF ** -0.5),
        "mix_norm": 1.0 + nrm(ks[5], (DEPTH, D_MODEL), 0.02),
        "ffn2_norm": 1.0 + nrm(ks[6], (DEPTH, D_MODEL), 0.02),
        "ffn2_w_gate_up": nrm(ks[7], (DEPTH, D_MODEL, 2 * D_FF), D_MODEL ** -0.5),
        "ffn2_w_down": nrm(ks[8], (DEPTH, D_FF, D_MODEL), D_FF ** -0.5),
        "ssm_w_in": nrm(ks[9], (N_A_LAYERS, D_MODEL, H), D_MODEL ** -0.5),
        "ssm_lambda_re": -0.5 + nrm(ks[10], (N_A_LAYERS, G, P), 0.01),
        "ssm_lambda_im": jnp.pi * jnp.arange(P, dtype=f32) + nrm(ks[11], (N_A_LAYERS, G, P), 0.01),
        "ssm_b_re": nrm(ks[12], (N_A_LAYERS, G, P, C), (2 * C) ** -0.5),
        "ssm_b_im": nrm(ks[13], (N_A_LAYERS, G, P, C), (2 * C) ** -0.5),
        "ssm_c_re": nrm(ks[14], (N_A_LAYERS, G, C, P), P ** -0.5),
        "ssm_c_im": nrm(ks[15], (N_A_LAYERS, G, C, P), P ** -0.5),
        "ssm_log_step": jax.random.uniform(ks[16], (N_A_LAYERS, G), f32,
                                           minval=math.log(STEP_MIN), maxval=math.log(STEP_MAX)),
        "ssm_d": nrm(ks[17], (N_A_LAYERS, H), 1.0),
        "ssm_w_out": nrm(ks[18], (N_A_LAYERS, H, 2 * D_MODEL), H ** -0.5),
        "kv_norm": 1.0 + nrm(ks[19], (D_MODEL,), 0.02),
        "w_kv": nrm(ks[20], (D_MODEL, 2 * N_KV_HEADS * HEAD_DIM), D_MODEL ** -0.5),
        "k_norm": 1.0 + nrm(ks[21], (HEAD_DIM,), 0.02),
        "attn_w_q": nrm(ks[22], (N_B_LAYERS, D_MODEL, N_Q_HEADS * HEAD_DIM), D_MODEL ** -0.5),
        "q_norm": 1.0 + nrm(ks[23], (N_B_LAYERS, HEAD_DIM), 0.02),
        "attn_sinks": nrm(ks[24], (N_B_LAYERS, N_Q_HEADS), 0.5),
        "attn_w_o": nrm(ks[25], (N_B_LAYERS, N_Q_HEADS * HEAD_DIM, D_MODEL), (N_Q_HEADS * HEAD_DIM) ** -0.5),
    }


def reference(x, meta_tokens, ffn1_norm, ffn1_w_gate_up, ffn1_w_down, mix_norm, ffn2_norm,
              ffn2_w_gate_up, ffn2_w_down, ssm_w_in, ssm_lambda_re, ssm_lambda_im, ssm_b_re,
              ssm_b_im, ssm_c_re, ssm_c_im, ssm_log_step, ssm_d, ssm_w_out, kv_norm, w_kv,
              k_norm, attn_w_q, q_norm, attn_sinks, attn_w_o):
    bsz = x.shape[0]
    meta = jnp.broadcast_to(meta_tokens.astype(x.dtype)[None], (bsz, N_META, D_MODEL))
    h = jnp.concatenate([meta, x], axis=1)
    k = v = None
    for layer in range(DEPTH):
        if layer == N_A_LAYERS:
            k, v = shared_kv(h, kv_norm, w_kv, k_norm)
            h = h[:, N_META:]
        h = h + 0.5 * swiglu_ffn(h, ffn1_norm[layer], ffn1_w_gate_up[layer], ffn1_w_down[layer])
        hn = rms_norm(h, mix_norm[layer])
        if layer < N_A_LAYERS:
            h = h + s5_mixer(hn, ssm_w_in[layer], ssm_lambda_re[layer], ssm_lambda_im[layer],
                             ssm_b_re[layer], ssm_b_im[layer], ssm_c_re[layer], ssm_c_im[layer],
                             ssm_log_step[layer], ssm_d[layer], ssm_w_out[layer])
        else:
            j = layer - N_A_LAYERS
            h = h + swa_sink_attention(hn, k, v, attn_w_q[j], q_norm[j], attn_sinks[j], attn_w_o[j])
        h = h + 0.5 * swiglu_ffn(h, ffn2_norm[layer], ffn2_w_gate_up[layer], ffn2_w_down[layer])
    return h
```

```cpp
#include <hip/hip_runtime.h>
#include <hip/hip_cooperative_groups.h>
#include <cstdio>
#include <cstdint>
namespace cg = cooperative_groups;

#define LAS __attribute__((address_space(3)))
typedef unsigned short bf16_t;
typedef short bf16x8 __attribute__((ext_vector_type(8)));
typedef float f32x4 __attribute__((ext_vector_type(4)));
typedef float f32x2 __attribute__((ext_vector_type(2)));
typedef unsigned u32x4 __attribute__((ext_vector_type(4)));
typedef unsigned u32x2 __attribute__((ext_vector_type(2)));

constexpr int DM = 1024, NB = 16, SEQ = 4096, NMETA = 16, FF = 2816, SW = 512, SG = 32, SP = 64, SC = 16, HD = 64, NQH = 16, NKVH = 4;
constexpr int MR = NB * SEQ;
constexpr int MT = MR + 256;
constexpr int LSEQ = SEQ + NMETA;
constexpr float EPS = 1e-6f;
constexpr int KC = 1152;

constexpr size_t al256(size_t x) { return (x + 255) & ~(size_t)255; }
constexpr size_t WS_WGU = 1 << 20;
constexpr size_t SZ_WGU = (size_t)2 * FF * DM * 2;
constexpr size_t WS_WD = WS_WGU + 4 * SZ_WGU;
constexpr size_t SZ_WD = (size_t)DM * FF * 2;
constexpr size_t WS_WIN = WS_WD + 4 * SZ_WD;
constexpr size_t WS_WOUT = WS_WIN + (size_t)SW * DM * 2;
constexpr size_t WS_WKV = WS_WOUT + (size_t)2 * DM * SW * 2;
constexpr size_t WS_WQ = WS_WKV + (size_t)512 * DM * 2;
constexpr size_t WS_WO = WS_WQ + (size_t)DM * DM * 2;
constexpr size_t WS_KMAT = WS_WO + (size_t)DM * DM * 2;
constexpr size_t WS_MEND = WS_KMAT + (size_t)SG * 1024 * KC * 2;
constexpr size_t WS_KD = WS_MEND + (size_t)SG * 256 * 1024 * 2;
constexpr size_t WS_APOW = WS_KD + (size_t)SG * 64 * 256 * 4;
constexpr size_t WS_BBAR = al256(WS_APOW + (size_t)SG * 65 * 64 * 2 * 4);
constexpr size_t WS_ROPE = al256(WS_BBAR + (size_t)SG * 64 * 16 * 2 * 4);
constexpr size_t WS_SSQ = al256(WS_ROPE + (size_t)LSEQ * 32 * 2 * 4);
constexpr size_t WS_HMETA = al256(WS_SSQ + (size_t)6 * MT * 4);
constexpr size_t WS_HB = al256(WS_HMETA + (size_t)256 * DM * 4);
constexpr size_t WS_KB = al256(WS_HB + (size_t)MT * DM * 2);
constexpr size_t WS_VB = al256(WS_KB + (size_t)MT * 256 * 2);
constexpr size_t WS_ACT = al256(WS_VB + (size_t)MT * 256 * 2);
constexpr size_t WS_END = al256(WS_ACT + (size_t)MT * FF * 2);
constexpr size_t WS_UG = WS_ACT;
constexpr size_t WS_YB = WS_ACT + ((size_t)80 << 20);
constexpr size_t WS_SLOC = WS_ACT + ((size_t)160 << 20);
constexpr size_t WS_UMETA = WS_ACT + ((size_t)180 << 20);
constexpr size_t WS_SMETA = WS_UMETA + 65536;
constexpr size_t WS_QB = WS_ACT;
constexpr size_t WS_OB = WS_ACT + (size_t)MR * DM * 2;
static_assert(WS_UG + (size_t)SG * 1024 * KC * 2 <= WS_YB && WS_YB + (size_t)MT * SW * 2 <= WS_SLOC && WS_SLOC + (size_t)SG * 1024 * 128 * 4 <= WS_UMETA && WS_SMETA + 16384 <= WS_END, "ssm overlay");
static_assert(WS_OB + (size_t)MR * DM * 2 <= WS_END && WS_END <= ((size_t)1 << 30), "ws map");

constexpr int LDS_STAGE = 131072;
constexpr int LDS_ROWTBL = LDS_STAGE + 2048;
constexpr int LDS_BYTES = 147456;

__device__ __forceinline__ unsigned cvt_pk_bf16(float lo, float hi) { unsigned r; asm volatile("v_cvt_pk_bf16_f32 %0, %1, %2" : "=v"(r) : "v"(lo), "v"(hi)); return r; }
__device__ __forceinline__ float bf2f(bf16_t b) { return __uint_as_float(((unsigned)b) << 16); }
__device__ __forceinline__ bf16_t f2bf(float f) { return (bf16_t)(cvt_pk_bf16(f, 0.f) & 0xffffu); }
__device__ __forceinline__ u32x4 pack8(f32x4 a, f32x4 b) { u32x4 w; w.x = cvt_pk_bf16(a[0], a[1]); w.y = cvt_pk_bf16(a[2], a[3]); w.z = cvt_pk_bf16(b[0], b[1]); w.w = cvt_pk_bf16(b[2], b[3]); return w; }
__device__ __forceinline__ float fast_sigmoid(float x) { return __builtin_amdgcn_rcpf(1.f + __builtin_amdgcn_exp2f(-1.4426950408889634f * x)); }
__device__ __forceinline__ float gelu_tanh(float y) {
    const float z = 0.7978845608028654f * (y + 0.044715f * y * y * y);
    return y * fast_sigmoid(2.f * z);
}

namespace pg8 {
constexpr int BM = 256, BK = 64, HALF = 128, HTB = HALF * BK * 2, NXCD = 8, WGM = 8;
__host__ __device__ __forceinline__ int lds_byte(int r, int c) { const int st = (r >> 4) * 2 + (c >> 5), rr = r & 15, cc = c & 31, ob = rr * 64 + cc * 2; return st * 1024 + (ob ^ (((ob >> 9) & 1) << 5)); }
__host__ __device__ __forceinline__ void stage_rc(int b, int& R, int& C) { const int st = b / 1024, sb = b % 1024, swz = sb ^ (((sb >> 9) & 1) << 5); R = (st >> 1) * 16 + swz / 64; C = (st & 1) * 32 + (swz % 64) / 2; }
__host__ __device__ __forceinline__ int perm32(int rho) { const int n = rho >> 4, i = rho & 15; return 8 * (i >> 2) + 4 * n + (i & 3); }

struct Unit { int pm, pn; };
struct Gemm { const bf16_t* A; const bf16_t* Bt; int lda, ldb, K; int kstepA = 0; long tstepA_ = 0; int kstepB = 0; long tstepB_ = 0; };

struct StaticOrder {
    int nM, nN, nwg, G, c;
    __device__ __forceinline__ void init(int M, int N, int G_, int c_) { nM = M / BM; nN = N / BM; nwg = nM * nN; G = G_; c = c_; }
    __device__ __forceinline__ bool next(int i, Unit& u) const {
        const long L = (long)i * G + c; if (L >= nwg) return false;
        int wgid = (int)L; { const int q = nwg / NXCD, r = nwg % NXCD, xcd = wgid % NXCD, off = wgid / NXCD; wgid = (xcd < r ? xcd * (q + 1) : r * (q + 1) + (xcd - r) * q) + off; }
        const int nig = WGM * nN, gid = wgid / nig, fm = gid * WGM, gsz = (nM - fm) < WGM ? (nM - fm) : WGM;
        u.pm = fm + ((wgid % nig) % gsz); u.pn = (wgid % nig) / gsz; return true;
    }
};
struct BatchOrder {
    int nb, nM, nN, G, c;
    __device__ __forceinline__ void init(int nb_, int nM_, int nN_, int G_, int c_) { nb = nb_; nM = nM_; nN = nN_; G = G_; c = c_; }
    __device__ __forceinline__ bool next(int i, Unit& u) const {
        const int L = i * G + c; if (L >= nb * nM * nN) return false;
        const int b = L / (nM * nN), r = L % (nM * nN);
        u.pm = b * nM + r % nM; u.pn = b * nN + r / nM; return true;
    }
};

template <class Epi, class Sched>
__device__ __forceinline__ void gemm_phase(LAS unsigned char* lds, const Gemm g, const Sched& S, const Epi& E) {
    const int tid = threadIdx.x, wid = __builtin_amdgcn_readfirstlane(tid >> 6), lane = tid & 63, wr = wid >> 2, wc = wid & 3, fr = lane & 15, fq = lane >> 4;
    const int K = g.K, nt = K / BK;
    unsigned voffA[2], voffB[2];
#pragma unroll
    for (int i = 0; i < 2; ++i) { int R, C; stage_rc(tid * 16 + i * 8192, R, C); const int Rb = (R & ~31) + perm32(R & 31);
        voffA[i] = (unsigned)(R * g.lda + C) * 2u; voffB[i] = (unsigned)(Rb * g.ldb + C) * 2u; }
    const size_t kstep = (size_t)(BK * 2), kstepA = g.kstepA ? (size_t)g.kstepA : kstep, kstepB = g.kstepB ? (size_t)g.kstepB : kstep;
    const size_t hstepA = (size_t)HALF * g.lda * 2, hstepB = (size_t)HALF * g.ldb * 2;
    const size_t tstepA = g.tstepA_ ? (size_t)g.tstepA_ : 2 * hstepA, tstepB = g.tstepB_ ? (size_t)g.tstepB_ : 2 * hstepB;
    const unsigned ldsw = (unsigned)wid * 1024u;
    const int aoff = lds_byte(wr * 64 + fr, fq * 8), boff = lds_byte(wc * 32 + fr, fq * 8);
#define PG8_SA(b, h) (((b) * 2 + (h)) * HTB)
#define PG8_SB(b, h) ((4 + (b) * 2 + (h)) * HTB)
#define PG8_STAGE(bufoff, gbase, voff) do { _Pragma("unroll") for (int _i = 0; _i < 2; ++_i) \
        __builtin_amdgcn_global_load_lds((const unsigned*)((const char*)(gbase) + (voff)[_i]), (LAS unsigned*)(lds + (bufoff) + ldsw + _i * 8192), 16, 0, 0); } while (0)
#define PG8_LDA(dst, b, h) do { _Pragma("unroll") for (int m = 0; m < 4; ++m) _Pragma("unroll") for (int k = 0; k < 2; ++k) dst[m][k] = *(const LAS bf16x8*)(lds + PG8_SA(b, h) + aoff + m * 2048 + k * 1024); } while (0)
#define PG8_LDB(dst, b, h) do { _Pragma("unroll") for (int n = 0; n < 2; ++n) _Pragma("unroll") for (int k = 0; k < 2; ++k) dst[n][k] = *(const LAS bf16x8*)(lds + PG8_SB(b, h) + boff + n * 2048 + k * 1024); } while (0)
#define PG8_MMA(ai, bj, At, Bt) do { __builtin_amdgcn_s_setprio(1); _Pragma("unroll") for (int m = 0; m < 4; ++m) _Pragma("unroll") for (int n = 0; n < 2; ++n) _Pragma("unroll") for (int k = 0; k < 2; ++k) \
        acc[ai][bj][m][n] = __builtin_amdgcn_mfma_f32_16x16x32_bf16(Bt[n][k], At[m][k], acc[ai][bj][m][n], 0, 0, 0); __builtin_amdgcn_s_setprio(0); } while (0)
#define PG8_WAIT_V(n) asm volatile("s_waitcnt vmcnt(" #n ")" ::: "memory")
#define PG8_WAIT_L(n) asm volatile("s_waitcnt lgkmcnt(" #n ")" ::: "memory")
#define PG8_BAR __builtin_amdgcn_s_barrier()
#define PG8_SCHED __builtin_amdgcn_sched_barrier(0)
    Unit cur, nxt; int ui = 0;
    if (!S.next(0, cur)) return;
    f32x4 acc[2][2][4][2];
#pragma unroll
    for (int a = 0; a < 2; ++a)
#pragma unroll
        for (int b = 0; b < 2; ++b)
#pragma unroll
            for (int m = 0; m < 4; ++m)
#pragma unroll
                for (int n = 0; n < 2; ++n) acc[a][b][m][n] = (f32x4){0.f, 0.f, 0.f, 0.f};
    bf16x8 At[4][2], B0[2][2], B1[2][2];
    const char* cA = (const char*)g.A + (size_t)cur.pm * tstepA; const char* cB = (const char*)g.Bt + (size_t)cur.pn * tstepB;
#define PG8_ROWTBL(uidx, unit) do { if constexpr (Epi::ROWTBL) { if (wid < 4) __builtin_amdgcn_global_load_lds((const unsigned*)(E.rowtbl_src() + (unit).pm * 256 + wid * 64 + lane), \
        (LAS unsigned*)(lds + LDS_ROWTBL + ((uidx) & 1) * 1024 + wid * 256), 4, 0, 0); } } while (0)
    PG8_ROWTBL(0, cur);
    PG8_STAGE(PG8_SB(0, 0), cB, voffB); PG8_STAGE(PG8_SB(0, 1), cB + hstepB, voffB); PG8_STAGE(PG8_SA(0, 0), cA, voffA); PG8_STAGE(PG8_SA(0, 1), cA + hstepA, voffA);
    if (wr == 1) PG8_BAR;
    PG8_WAIT_V(2); PG8_BAR;
    PG8_STAGE(PG8_SB(1, 0), cB + kstepB, voffB); PG8_STAGE(PG8_SA(1, 0), cA + kstepA, voffA); PG8_STAGE(PG8_SB(1, 1), cB + hstepB + kstepB, voffB);
    PG8_WAIT_V(6); PG8_BAR;
    for (;;) {
        const bool has_next = S.next(ui + 1, nxt);
        const char* nA = has_next ? (const char*)g.A + (size_t)nxt.pm * tstepA : cA; const char* nB = has_next ? (const char*)g.Bt + (size_t)nxt.pn * tstepB : cB;
        for (int t = 0; t < nt; t += 2) {
            const bool last = (t == nt - 2);
            const char* a1 = cA + (size_t)(t + 1) * kstepA;
            const char* a2 = last ? nA : cA + (size_t)(t + 2) * kstepA; const char* b2 = last ? nB : cB + (size_t)(t + 2) * kstepB;
            const char* a3 = a2 + kstepA; const char* b3 = b2 + kstepB;
            PG8_LDB(B0, 0, 0); PG8_LDB(B1, 0, 1); PG8_SCHED; PG8_LDA(At, 0, 0); PG8_STAGE(PG8_SA(1, 1), a1 + hstepA, voffA);
            PG8_WAIT_V(8); PG8_WAIT_L(0); PG8_BAR; PG8_MMA(0, 0, At, B0); PG8_MMA(0, 1, At, B1); PG8_BAR; PG8_SCHED;
            PG8_LDA(At, 0, 1); PG8_STAGE(PG8_SB(0, 0), b2, voffB); PG8_STAGE(PG8_SB(0, 1), b2 + hstepB, voffB); PG8_STAGE(PG8_SA(0, 0), a2, voffA);
            PG8_WAIT_V(8); PG8_WAIT_L(0); PG8_BAR; PG8_MMA(1, 0, At, B0); PG8_MMA(1, 1, At, B1); PG8_BAR; PG8_SCHED;
            PG8_LDB(B0, 1, 0); PG8_LDB(B1, 1, 1); PG8_SCHED; PG8_LDA(At, 1, 0); PG8_STAGE(PG8_SA(0, 1), a2 + hstepA, voffA);
            PG8_WAIT_V(8); PG8_WAIT_L(0); PG8_BAR; PG8_MMA(0, 0, At, B0); PG8_MMA(0, 1, At, B1); PG8_BAR; PG8_SCHED;
            PG8_LDA(At, 1, 1); PG8_STAGE(PG8_SB(1, 0), b3, voffB); PG8_STAGE(PG8_SB(1, 1), b3 + hstepB, voffB); PG8_STAGE(PG8_SA(1, 0), a3, voffA);
            PG8_WAIT_V(8); PG8_WAIT_L(0); PG8_BAR; PG8_MMA(1, 0, At, B0); PG8_MMA(1, 1, At, B1); PG8_BAR; PG8_SCHED;
        }
        if (wr == 0) PG8_BAR;
        E(acc, cur, wr, wc, fr, fq, (const LAS float*)(lds + LDS_ROWTBL + (ui & 1) * 1024));
        if (!has_next) break;
#pragma unroll
        for (int a = 0; a < 2; ++a)
#pragma unroll
            for (int b = 0; b < 2; ++b)
#pragma unroll
                for (int m = 0; m < 4; ++m)
#pragma unroll
                    for (int n = 0; n < 2; ++n) acc[a][b][m][n] = (f32x4){0.f, 0.f, 0.f, 0.f};
        cur = nxt; cA = nA; cB = nB; ++ui;
        PG8_ROWTBL(ui, cur);
        if (wr == 1) PG8_BAR;
    }
    PG8_WAIT_V(0);
    PG8_BAR;
#undef PG8_ROWTBL
#undef PG8_SA
#undef PG8_SB
#undef PG8_STAGE
#undef PG8_LDA
#undef PG8_LDB
#undef PG8_MMA
#undef PG8_WAIT_V
#undef PG8_WAIT_L
#undef PG8_BAR
#undef PG8_SCHED
}
}
using pg8::Unit;

struct Params {
    const float* in[26];
    float* out;
    unsigned char* ws;
};

__device__ __forceinline__ float* hrow(float* out, float* hmeta, int row) { return row < MR ? out + (size_t)row * DM : hmeta + (size_t)(row - MR) * DM; }

constexpr int ACT_KT = FF / 64;
__device__ __forceinline__ size_t act_off(int row, int j) { return ((((size_t)(row >> 8) * ACT_KT + (j >> 6)) * 256 + (row & 255)) << 6) + (j & 63); }
__device__ __forceinline__ void load_rs8(float (&rs)[8], const float* ssq, int pm, int wr, int fr) {
#pragma unroll
    for (int ai = 0; ai < 2; ++ai)
#pragma unroll
        for (int m = 0; m < 4; ++m) rs[ai * 4 + m] = ssq[pm * 256 + ai * 128 + wr * 64 + m * 16 + fr];
#pragma unroll
    for (int i = 0; i < 8; ++i) rs[i] = __builtin_amdgcn_rsqf(rs[i] * (1.0f / DM) + EPS);
}
struct EpiSwiglu {
    bf16_t* act; const float* ssq;
    static constexpr bool ROWTBL = true; __device__ __forceinline__ const float* rowtbl_src() const { return ssq; }
    __device__ __forceinline__ void operator()(const f32x4 (&acc)[2][2][4][2], const Unit& u, int wr, int wc, int fr, int fq, const LAS float* tbl) const {
        const int col0 = u.pn * 128 + wc * 32 + 8 * fq;
        float rs8[8];
#pragma unroll
        for (int i = 0; i < 8; ++i) rs8[i] = __builtin_amdgcn_rsqf(tbl[(i >> 2) * 128 + wr * 64 + (i & 3) * 16 + fr] * (1.0f / DM) + EPS);
#pragma unroll
        for (int ai = 0; ai < 2; ++ai)
#pragma unroll
            for (int m = 0; m < 4; ++m) {
                const int row = u.pm * 256 + ai * 128 + wr * 64 + m * 16 + fr;
                const float rs = rs8[ai * 4 + m], nk = -1.4426950408889634f * rs, r2 = rs * rs;
                f32x4 o[2];
#pragma unroll
                for (int n = 0; n < 2; ++n) {
                    const f32x4 a = acc[ai][0][m][n], b = acc[ai][1][m][n];
                    const f32x4 t = a * nk; f32x4 ex;
#pragma unroll
                    for (int e = 0; e < 4; ++e) ex[e] = __builtin_amdgcn_exp2f(t[e]);
                    const f32x4 dn = ex + 1.0f; f32x4 sg;
#pragma unroll
                    for (int e = 0; e < 4; ++e) sg[e] = __builtin_amdgcn_rcpf(dn[e]);
                    o[n] = ((a * b) * r2) * sg;
                }
                __builtin_nontemporal_store(pack8(o[0], o[1]), (u32x4*)(act + act_off(row, col0)));
            }
    }
};

__device__ __forceinline__ void unpack8(u32x4 w, f32x4& a, f32x4& b) {
    a[0] = __uint_as_float(w.x << 16); a[1] = __uint_as_float(w.x & 0xffff0000u); a[2] = __uint_as_float(w.y << 16); a[3] = __uint_as_float(w.y & 0xffff0000u);
    b[0] = __uint_as_float(w.z << 16); b[1] = __uint_as_float(w.z & 0xffff0000u); b[2] = __uint_as_float(w.w << 16); b[3] = __uint_as_float(w.w & 0xffff0000u);
}
template <int MODE  > struct EpiRes {
    const float* x; const float* meta; float* out; bf16_t* hb; float* ssq_out; float coef;
    static constexpr bool ROWTBL = false;
    __device__ __forceinline__ void operator()(const f32x4 (&acc)[2][2][4][2], const Unit& u, int wr, int wc, int fr, int fq, const LAS float* tbl) const {
        const int col0 = u.pn * 256 + wc * 32 + 8 * fq;
#pragma unroll
        for (int ai = 0; ai < 2; ++ai)
#pragma unroll
            for (int m = 0; m < 4; ++m) {
                const int row = u.pm * 256 + ai * 128 + wr * 64 + m * 16 + fr;
                const float* src = nullptr;
                if (MODE == 0) { if (row < MR) src = x + (size_t)row * DM; else if (row < MR + NMETA) src = meta + (size_t)(row - MR) * DM; }
                bf16_t* hrow_ = hb + (size_t)row * DM + col0;
                float ss = 0.f;
#pragma unroll
                for (int bj = 0; bj < 2; ++bj) {
                    f32x4 r0 = (f32x4){0.f, 0.f, 0.f, 0.f}, r1 = r0;
                    if (MODE == 0) { if (src) { r0 = *(const f32x4*)(src + col0 + bj * 128); r1 = *(const f32x4*)(src + col0 + bj * 128 + 4); } }
                    else unpack8(*(const u32x4*)(hrow_ + bj * 128), r0, r1);
                    const f32x4 v0 = r0 + acc[ai][bj][m][0] * coef, v1 = r1 + acc[ai][bj][m][1] * coef;
                    if (MODE == 2) { float* op = out + (size_t)row * DM + col0 + bj * 128; __builtin_nontemporal_store(v0, (f32x4*)op); __builtin_nontemporal_store(v1, (f32x4*)(op + 4)); }
                    else {
                        *(u32x4*)(hrow_ + bj * 128) = pack8(v0, v1);
                        ss += v0[0] * v0[0] + v0[1] * v0[1] + v0[2] * v0[2] + v0[3] * v0[3] + v1[0] * v1[0] + v1[1] * v1[1] + v1[2] * v1[2] + v1[3] * v1[3];
                    }
                }
                if (MODE != 2) { ss += __shfl_xor(ss, 16); ss += __shfl_xor(ss, 32); if (fq == 0) unsafeAtomicAdd(ssq_out + row, ss); }
            }
    }
};

struct EpiGlu {
    bf16_t* hb; float* ssq_out;
    static constexpr bool ROWTBL = false;
    __device__ __forceinline__ void operator()(const f32x4 (&acc)[2][2][4][2], const Unit& u, int wr, int wc, int fr, int fq, const LAS float* tbl) const {
        const int col0 = u.pn * 128 + wc * 32 + 8 * fq;
#pragma unroll
        for (int ai = 0; ai < 2; ++ai)
#pragma unroll
            for (int m = 0; m < 4; ++m) {
                const int row = u.pm * 256 + ai * 128 + wr * 64 + m * 16 + fr;
                bf16_t* hp = hb + (size_t)row * DM + col0;
                f32x4 v[2]; unpack8(*(const u32x4*)hp, v[0], v[1]);
                float ss = 0.f;
#pragma unroll
                for (int n = 0; n < 2; ++n) {
                    const f32x4 t = acc[ai][1][m][n] * (-1.4426950408889634f); f32x4 ex;
#pragma unroll
                    for (int e = 0; e < 4; ++e) ex[e] = __builtin_amdgcn_exp2f(t[e]);
                    const f32x4 dn = ex + 1.0f; f32x4 sg;
#pragma unroll
                    for (int e = 0; e < 4; ++e) sg[e] = __builtin_amdgcn_rcpf(dn[e]);
                    v[n] = v[n] + acc[ai][0][m][n] * sg;
                    const f32x4 sq = v[n] * v[n]; ss += (sq[0] + sq[1]) + (sq[2] + sq[3]);
                }
                *(u32x4*)hp = pack8(v[0], v[1]);
                ss += __shfl_xor(ss, 16); ss += __shfl_xor(ss, 32); if (fq == 0) unsafeAtomicAdd(ssq_out + row, ss);
            }
    }
};

struct EpiWin {
    bf16_t* ug; float* umeta; const float* ssq;
    static constexpr bool ROWTBL = false;
    __device__ __forceinline__ void operator()(const f32x4 (&acc)[2][2][4][2], const Unit& u, int wr, int wc, int fr, int fq, const LAS float* tbl) const {
#pragma unroll
        for (int ai = 0; ai < 2; ++ai)
#pragma unroll
            for (int m = 0; m < 4; ++m) {
                const int row = u.pm * 256 + ai * 128 + wr * 64 + m * 16 + fr;
                const float rs = __builtin_amdgcn_rsqf(ssq[row] * (1.0f / DM) + EPS);
#pragma unroll
                for (int bj = 0; bj < 2; ++bj) {
                    const int col0 = u.pn * 256 + bj * 128 + wc * 32 + 8 * fq, g = col0 >> 4, c0 = col0 & 15;
                    const f32x4 v0 = acc[ai][bj][m][0] * rs, v1 = acc[ai][bj][m][1] * rs;
                    if (row < MR) { const int chunk = row >> 6, t = row & 63; *(u32x4*)(ug + ((size_t)(g * 1024 + chunk) * KC + t * 16 + c0)) = pack8(v0, v1); }
                    else if (row < MR + NMETA) { float* p = umeta + (size_t)(row - MR) * SW + col0; *(f32x4*)p = v0; *(f32x4*)(p + 4) = v1; }
                }
            }
    }
};

struct EpiSloc {
    float* sloc;
    static constexpr bool ROWTBL = false;
    __device__ __forceinline__ void operator()(const f32x4 (&acc)[2][2][4][2], const Unit& u, int wr, int wc, int fr, int fq, const LAS float* tbl) const {
        const int g = u.pn, col0 = wc * 32 + 8 * fq;
#pragma unroll
        for (int ai = 0; ai < 2; ++ai)
#pragma unroll
            for (int m = 0; m < 4; ++m) {
                const int chunk = (u.pm & 3) * 256 + ai * 128 + wr * 64 + m * 16 + fr;
                float* p = sloc + ((size_t)(g * 1024 + chunk) * 128 + col0);
                *(f32x4*)p = acc[ai][0][m][0]; *(f32x4*)(p + 4) = acc[ai][0][m][1];
            }
    }
};

struct EpiY {
    bf16_t* yb;
    static constexpr bool ROWTBL = false;
    __device__ __forceinline__ void operator()(const f32x4 (&acc)[2][2][4][2], const Unit& u, int wr, int wc, int fr, int fq, const LAS float* tbl) const {
        const int g = u.pm >> 2;
#pragma unroll
        for (int ai = 0; ai < 2; ++ai)
#pragma unroll
            for (int m = 0; m < 4; ++m) {
                const int chunk = (u.pm & 3) * 256 + ai * 128 + wr * 64 + m * 16 + fr;
#pragma unroll
                for (int bj = 0; bj < 2; ++bj) {
                    const int cn = (u.pn & 3) * 256 + bj * 128 + wc * 32 + 8 * fq, t = cn >> 4, c0 = cn & 15;
                    f32x4 o[2];
#pragma unroll
                    for (int n = 0; n < 2; ++n) {
                        const f32x4 y = acc[ai][bj][m][n];
                        const f32x4 t = (y * (y * y * (-0.044715f * 2.302208198f) + (-2.302208198f))); f32x4 ex;
#pragma unroll
                        for (int e = 0; e < 4; ++e) ex[e] = __builtin_amdgcn_exp2f(t[e]);
                        const f32x4 dn = ex + 1.0f; f32x4 sg;
#pragma unroll
                        for (int e = 0; e < 4; ++e) sg[e] = __builtin_amdgcn_rcpf(dn[e]);
                        o[n] = y * sg;
                    }
                    *(u32x4*)(yb + ((size_t)(chunk * 64 + t) * SW + 16 * g + c0)) = pack8(o[0], o[1]);
                }
            }
    }
};

template <bool ISQ> struct EpiHead {
    bf16_t* o0; bf16_t* o1;
    const float* ssq; const float* gain; const float* rope; float scale;
    static constexpr bool ROWTBL = false;
    __device__ __forceinline__ void operator()(const f32x4 (&acc)[2][2][4][2], const Unit& u, int wr, int wc, int fr, int fq, const LAS float* tbl) const {
        const bool isv = (!ISQ) && (u.pn == 1);
        const int ld = ISQ ? DM : 256;
        const int hcol = (ISQ ? u.pn * 256 : 0) + wc * 64 + 8 * fq;
        f32x4 gn[2][2];
#pragma unroll
        for (int bj = 0; bj < 2; ++bj)
#pragma unroll
            for (int n = 0; n < 2; ++n) gn[bj][n] = *(const f32x4*)(gain + 32 * bj + 8 * fq + 4 * n);
#pragma unroll
        for (int ai = 0; ai < 2; ++ai)
#pragma unroll
            for (int m = 0; m < 4; ++m) {
                const int row = u.pm * 256 + ai * 128 + wr * 64 + m * 16 + fr;
                const float rs = __builtin_amdgcn_rsqf(ssq[row] * (1.0f / DM) + EPS);
                f32x4 v[2][2];
#pragma unroll
                for (int bj = 0; bj < 2; ++bj)
#pragma unroll
                    for (int n = 0; n < 2; ++n) v[bj][n] = acc[ai][bj][m][n] * rs;
                if (isv) {
                    bf16_t* p = o1 + (size_t)row * 256 + hcol;
                    *(u32x4*)p = pack8(v[0][0], v[0][1]); *(u32x4*)(p + 32) = pack8(v[1][0], v[1][1]);
                } else {
                    float ss = 0.f;
#pragma unroll
                    for (int bj = 0; bj < 2; ++bj)
#pragma unroll
                        for (int n = 0; n < 2; ++n) ss += v[bj][n][0] * v[bj][n][0] + v[bj][n][1] * v[bj][n][1] + v[bj][n][2] * v[bj][n][2] + v[bj][n][3] * v[bj][n][3];
                    ss += __shfl_xor(ss, 16); ss += __shfl_xor(ss, 32);
                    const float rk = __builtin_amdgcn_rsqf(ss * (1.0f / HD) + EPS) * scale;
                    const int pos = row < MR ? NMETA + (row & (SEQ - 1)) : ((row - MR) & 15);
                    const float* rp = rope + ((size_t)pos * 32 + 8 * fq) * 2;
                    f32x4 o[2][2];
#pragma unroll
                    for (int n = 0; n < 2; ++n) {
                        const f32x4 cs0 = *(const f32x4*)(rp + 8 * n), cs1 = *(const f32x4*)(rp + 8 * n + 4);
                        const f32x4 x1 = v[0][n] * gn[0][n] * rk, x2 = v[1][n] * gn[1][n] * rk;
                        o[0][n][0] = x1[0] * cs0[0] - x2[0] * cs0[1]; o[1][n][0] = x2[0] * cs0[0] + x1[0] * cs0[1];
                        o[0][n][1] = x1[1] * cs0[2] - x2[1] * cs0[3]; o[1][n][1] = x2[1] * cs0[2] + x1[1] * cs0[3];
                        o[0][n][2] = x1[2] * cs1[0] - x2[2] * cs1[1]; o[1][n][2] = x2[2] * cs1[0] + x1[2] * cs1[1];
                        o[0][n][3] = x1[3] * cs1[2] - x2[3] * cs1[3]; o[1][n][3] = x2[3] * cs1[2] + x1[3] * cs1[3];
                    }
                    bf16_t* p = o0 + (size_t)row * ld + hcol;
                    *(u32x4*)p = pack8(o[0][0], o[0][1]); *(u32x4*)(p + 32) = pack8(o[1][0], o[1][1]);
                }
            }
    }
};


template <int NT, int KS, bool ACT_TILED = false>
__device__ __forceinline__ void skinny_acc(f32x4 (&acc)[NT], LAS unsigned char* lds, const bf16_t* A, int lda, const bf16_t* Bt, int ldb, const int (&noff)[NT], int lane, int wave) {
    const int fr = lane & 15, fq = lane >> 4;
    const bf16_t* ap = A + (size_t)fr * lda + 8 * fq + 32 * KS * wave;
    bf16x8 a[KS], b[NT][KS];
#pragma unroll
    for (int k = 0; k < KS; ++k) a[k] = ACT_TILED ? *(const bf16x8*)(A + act_off(MR + fr, 32 * (KS * wave + k) + 8 * fq)) : *(const bf16x8*)(ap + 32 * k);
#pragma unroll
    for (int t = 0; t < NT; ++t) { const bf16_t* bp = Bt + (size_t)(noff[t] + fr) * ldb + 8 * fq + 32 * KS * wave;
#pragma unroll
        for (int k = 0; k < KS; ++k) b[t][k] = ACT_TILED ? *(const bf16x8*)(Bt + act_off(noff[t] + fr, 32 * (KS * wave + k) + 8 * fq)) : *(const bf16x8*)(bp + 32 * k); }
#pragma unroll
    for (int t = 0; t < NT; ++t) { acc[t] = (f32x4){0.f, 0.f, 0.f, 0.f};
#pragma unroll
        for (int k = 0; k < KS; ++k) acc[t] = __builtin_amdgcn_mfma_f32_16x16x32_bf16(b[t][k], a[k], acc[t], 0, 0, 0); }
    LAS f32x4* red = (LAS f32x4*)lds;
    __syncthreads();
#pragma unroll
    for (int t = 0; t < NT; ++t) red[(wave * NT + t) * 64 + lane] = acc[t];
    __syncthreads();
    if (wave == 0) {
#pragma unroll
        for (int t = 0; t < NT; ++t) { f32x4 s = red[t * 64 + lane];
#pragma unroll
            for (int w = 1; w < 8; ++w) s += red[(w * NT + t) * 64 + lane];
            acc[t] = s; }
    }
    __syncthreads();
}
__device__ __forceinline__ u32x2 pack4(f32x4 a) { u32x2 w; w.x = cvt_pk_bf16(a[0], a[1]); w.y = cvt_pk_bf16(a[2], a[3]); return w; }
__device__ __forceinline__ f32x4 unpack4(u32x2 w) { f32x4 a; a[0] = __uint_as_float(w.x << 16); a[1] = __uint_as_float(w.x & 0xffff0000u); a[2] = __uint_as_float(w.y << 16); a[3] = __uint_as_float(w.y & 0xffff0000u); return a; }

__device__ __forceinline__ void sk_swiglu(int item, const bf16_t* HB, const bf16_t* W, bf16_t* ACT, const float* ssq, int lane, int wave, LAS unsigned char* lds) {
    const int fr = lane & 15, fq = lane >> 4, j0 = 16 * item, pn = j0 >> 7, jj = j0 & 127;
    const int noff[2] = {256 * pn + jj, 256 * pn + 128 + jj};
    f32x4 acc[2]; skinny_acc<2, 4>(acc, lds, HB + (size_t)MR * DM, DM, W, DM, noff, lane, wave);
    if (wave == 0) {
    const float rs = __builtin_amdgcn_rsqf(ssq[MR + fr] * (1.0f / DM) + EPS);
    f32x4 o;
#pragma unroll
    for (int i = 0; i < 4; ++i) { const float a = acc[0][i] * rs, b = acc[1][i] * rs; o[i] = a * fast_sigmoid(a) * b; }
    *(u32x2*)(ACT + act_off(MR + fr, j0 + 4 * fq)) = pack4(o);
    }
}
__device__ __forceinline__ void sk_down(int item, const bf16_t* ACT, const bf16_t* W, bf16_t* HB, const float* meta  , float* ssq_out, int lane, int wave, LAS unsigned char* lds) {
    const int fr = lane & 15, fq = lane >> 4, c0 = 16 * item + 4 * fq;
    const int noff[1] = {16 * item};
    f32x4 acc[1]; skinny_acc<1, 11, true>(acc, lds, ACT, FF, W, FF, noff, lane, wave);
    if (wave == 0) {
    bf16_t* hp = HB + (size_t)(MR + fr) * DM + c0;
    const f32x4 r = meta ? *(const f32x4*)(meta + (size_t)fr * DM + c0) : unpack4(*(const u32x2*)hp);
    const f32x4 v = r + acc[0] * 0.5f;
    *(u32x2*)hp = pack4(v);
    float ss = v[0] * v[0] + v[1] * v[1] + v[2] * v[2] + v[3] * v[3];
    ss += __shfl_xor(ss, 16); ss += __shfl_xor(ss, 32); if (fq == 0) unsafeAtomicAdd(ssq_out + MR + fr, ss);
    }
}
__device__ __forceinline__ void sk_win(int item, const bf16_t* HB, const bf16_t* W, float* umeta, const float* ssq, int lane, int wave, LAS unsigned char* lds) {
    const int fr = lane & 15, fq = lane >> 4;
    const int noff[1] = {16 * item};
    f32x4 acc[1]; skinny_acc<1, 4>(acc, lds, HB + (size_t)MR * DM, DM, W, DM, noff, lane, wave);
    if (wave == 0) {
    const float rs = __builtin_amdgcn_rsqf(ssq[MR + fr] * (1.0f / DM) + EPS);
    *(f32x4*)(umeta + (size_t)fr * SW + 16 * item + 4 * fq) = acc[0] * rs;
    }
}
__device__ __forceinline__ void sk_glu(int item, const bf16_t* YB, const bf16_t* W, bf16_t* HB, float* ssq_out, int lane, int wave, LAS unsigned char* lds) {
    const int fr = lane & 15, fq = lane >> 4, j0 = 16 * item, pn = j0 >> 7, jj = j0 & 127;
    const int noff[2] = {256 * pn + jj, 256 * pn + 128 + jj};
    f32x4 acc[2]; skinny_acc<2, 2>(acc, lds, YB + (size_t)MR * SW, SW, W, SW, noff, lane, wave);
    if (wave == 0) {
    bf16_t* hp = HB + (size_t)(MR + fr) * DM + j0 + 4 * fq;
    f32x4 v = unpack4(*(const u32x2*)hp);
    float ss = 0.f;
#pragma unroll
    for (int i = 0; i < 4; ++i) { v[i] += acc[0][i] * fast_sigmoid(acc[1][i]); ss += v[i] * v[i]; }
    *(u32x2*)hp = pack4(v);
    ss += __shfl_xor(ss, 16); ss += __shfl_xor(ss, 32); if (fq == 0) unsafeAtomicAdd(ssq_out + MR + fr, ss);
    }
}
__device__ __forceinline__ void sk_kv(int item, const bf16_t* HB, const bf16_t* W, bf16_t* KB, bf16_t* VB, const float* ssq, const float* gain, const float* rope, int lane, int wave, LAS unsigned char* lds) {
    const int fr = lane & 15, fq = lane >> 4, kv = item >> 2, wc = item & 3;
    const int noff[4] = {256 * kv + 32 * wc, 256 * kv + 32 * wc + 16, 256 * kv + 128 + 32 * wc, 256 * kv + 128 + 32 * wc + 16};
    f32x4 acc[4]; skinny_acc<4, 4>(acc, lds, HB + (size_t)MR * DM, DM, W, DM, noff, lane, wave);
    if (wave == 0) {
    const float rs = __builtin_amdgcn_rsqf(ssq[MR + fr] * (1.0f / DM) + EPS);
    f32x4 v[4];
#pragma unroll
    for (int t = 0; t < 4; ++t) v[t] = acc[t] * rs;
    if (kv == 1) {
#pragma unroll
        for (int t = 0; t < 4; ++t) *(u32x2*)(VB + (size_t)(MR + fr) * 256 + wc * 64 + 16 * t + 4 * fq) = pack4(v[t]);
    } else {
        float ss = 0.f;
#pragma unroll
        for (int t = 0; t < 4; ++t) ss += v[t][0] * v[t][0] + v[t][1] * v[t][1] + v[t][2] * v[t][2] + v[t][3] * v[t][3];
        ss += __shfl_xor(ss, 16); ss += __shfl_xor(ss, 32);
        const float rk = __builtin_amdgcn_rsqf(ss * (1.0f / HD) + EPS);
        f32x4 o[4];
#pragma unroll
        for (int t = 0; t < 2; ++t) {
            const int d0 = 16 * t + 4 * fq;
            const f32x4 g1 = *(const f32x4*)(gain + d0), g2 = *(const f32x4*)(gain + 32 + d0);
            const float* rp = rope + ((size_t)fr * 32 + d0) * 2;
            const f32x4 cs0 = *(const f32x4*)rp, cs1 = *(const f32x4*)(rp + 4);
            const f32x4 x1 = v[t] * g1 * rk, x2 = v[t + 2] * g2 * rk;
            o[t][0] = x1[0] * cs0[0] - x2[0] * cs0[1]; o[t + 2][0] = x2[0] * cs0[0] + x1[0] * cs0[1];
            o[t][1] = x1[1] * cs0[2] - x2[1] * cs0[3]; o[t + 2][1] = x2[1] * cs0[2] + x1[1] * cs0[3];
            o[t][2] = x1[2] * cs1[0] - x2[2] * cs1[1]; o[t + 2][2] = x2[2] * cs1[0] + x1[2] * cs1[1];
            o[t][3] = x1[3] * cs1[2] - x2[3] * cs1[3]; o[t + 2][3] = x2[3] * cs1[2] + x1[3] * cs1[3];
        }
#pragma unroll
        for (int t = 0; t < 4; ++t) *(u32x2*)(KB + (size_t)(MR + fr) * 256 + wc * 64 + 16 * t + 4 * fq) = pack4(o[t]);
    }
    }
}

__device__ __forceinline__ int src_col(int n, int mode) {
    const int tb = n >> 8, r = n & 255;
    if (mode == 1) return (r < 128) ? tb * 128 + r : FF + tb * 128 + (r - 128);
    if (mode == 2) return (r < 128) ? tb * 128 + r : DM + tb * 128 + (r - 128);
    if (mode == 3) { const int bj = r >> 7, wc = (r >> 5) & 3, i = r & 31; return tb * 256 + 64 * wc + 32 * bj + i; }
    return n;
}
__device__ __forceinline__ void conv_wT(LAS float* scr, const float* W, int K, int Nsrc, const float* gain, bf16_t* Bt, int Ndst, int mode, int G, int wg, bool tiled = false) {
    const int tid = threadIdx.x, nkt = K / 64, ntiles = (Ndst / 128) * nkt;
    const int kk = tid >> 5, j4 = tid & 31, nn = tid >> 2, q = tid & 3;
    f32x4 v[4]; float gk[4];
    int tl = wg;
    if (tl < ntiles) {
        const int n0 = (tl / nkt) * 128, k0 = (tl % nkt) * 64, sc = src_col(n0 + (j4 >> 3) * 32, mode) + ((4 * j4) & 31);
#pragma unroll
        for (int s = 0; s < 4; ++s) { v[s] = __builtin_nontemporal_load((const f32x4*)(W + (size_t)(k0 + kk + 16 * s) * Nsrc + sc)); gk[s] = gain ? gain[k0 + kk + 16 * s] : 1.f; }
    }
    for (; tl < ntiles; tl += G) {
        const int n0 = (tl / nkt) * 128, k0 = (tl % nkt) * 64;
#pragma unroll
        for (int s = 0; s < 4; ++s) { const int k = kk + 16 * s;
            scr[k * 129 + 4 * j4] = v[s][0] * gk[s]; scr[k * 129 + 4 * j4 + 1] = v[s][1] * gk[s]; scr[k * 129 + 4 * j4 + 2] = v[s][2] * gk[s]; scr[k * 129 + 4 * j4 + 3] = v[s][3] * gk[s]; }
        __syncthreads();
        const int tn = tl + G;
        if (tn < ntiles) {
            const int n1 = (tn / nkt) * 128, k1 = (tn % nkt) * 64, sc = src_col(n1 + (j4 >> 3) * 32, mode) + ((4 * j4) & 31);
#pragma unroll
            for (int s = 0; s < 4; ++s) { v[s] = __builtin_nontemporal_load((const f32x4*)(W + (size_t)(k1 + kk + 16 * s) * Nsrc + sc)); gk[s] = gain ? gain[k1 + kk + 16 * s] : 1.f; }
        }
        { f32x4 a, b, c, d;
#pragma unroll
          for (int e = 0; e < 4; ++e) { a[e] = scr[(16 * q + e) * 129 + nn]; b[e] = scr[(16 * q + 4 + e) * 129 + nn]; c[e] = scr[(16 * q + 8 + e) * 129 + nn]; d[e] = scr[(16 * q + 12 + e) * 129 + nn]; }
          bf16_t* dst = tiled ? Bt + act_off(n0 + nn, k0 + 16 * q) : Bt + (size_t)(n0 + nn) * K + k0 + 16 * q;
          *(u32x4*)dst = pack8(a, b); *(u32x4*)(dst + 8) = pack8(c, d); }
        __syncthreads();
    }
}


typedef float f32x16 __attribute__((ext_vector_type(16)));
typedef short s16x4 __attribute__((ext_vector_type(4)));
typedef short v4i16_t __attribute__((ext_vector_type(4)));
typedef __bf16 bf16x2_t __attribute__((ext_vector_type(2)));
__device__ __forceinline__ unsigned cvtpk_s(float lo, float hi) { f32x2 v = {lo, hi}; bf16x2_t b = __builtin_convertvector(v, bf16x2_t); return __builtin_bit_cast(unsigned, b); }
__device__ __forceinline__ s16x4 vtr(LAS unsigned char* p) { return __builtin_bit_cast(s16x4, __builtin_amdgcn_ds_read_tr16_b64_v4i16((LAS v4i16_t*)p)); }
constexpr int KVS = 144;
constexpr int AT_KB = 0, AT_VB = 256 * KVS, AT_KM = 2 * 256 * KVS, AT_VM = AT_KM + 32 * KVS, AT_END = AT_VM + 32 * KVS;
static_assert(AT_END <= LDS_STAGE, "attention LDS");


template <bool BOUNDED>
__device__ __forceinline__ void attn_tile(LAS unsigned char* kbase, LAS unsigned char* vbase, const bf16x8 (&bq)[4], const f32x16& zero16, f32x16& o0, f32x16& o1, float& m, float& l,
                                          int r, int h, int troff, bool masked  , int lo, int hi) {
    f32x16 xs;
    { const bf16x8 ka = *(const LAS bf16x8*)(kbase + r * KVS + 16 * h); xs = __builtin_amdgcn_mfma_f32_32x32x16_bf16(ka, bq[0], zero16, 0, 0, 0); }
#pragma unroll
    for (int kd = 1; kd < 4; ++kd) { const bf16x8 ka = *(const LAS bf16x8*)(kbase + r * KVS + 32 * kd + 16 * h); xs = __builtin_amdgcn_mfma_f32_32x32x16_bf16(ka, bq[kd], xs, 0, 0, 0); }
    if (masked) {
        const int k0 = 4 * h;
#pragma unroll
        for (int i = 0; i < 16; ++i) { const int kr = (i & 3) + 8 * (i >> 2) + k0; xs[i] = (kr > lo && kr <= hi) ? xs[i] : -1e30f; }
    }
    float mnl;
    if (BOUNDED) mnl = m * 1.4426950408889634f;
    else {
        float tm = fmaxf(fmaxf(fmaxf(xs[0], xs[1]), fmaxf(xs[2], xs[3])), fmaxf(fmaxf(xs[4], xs[5]), fmaxf(xs[6], xs[7])));
        tm = fmaxf(tm, fmaxf(fmaxf(fmaxf(xs[8], xs[9]), fmaxf(xs[10], xs[11])), fmaxf(fmaxf(xs[12], xs[13]), fmaxf(xs[14], xs[15]))));
        tm = fmaxf(tm, __shfl_xor(tm, 32));
        const float mn = fmaxf(m, tm);
        if (__any(mn > m)) {
            const float sc = __builtin_amdgcn_exp2f((m - mn) * 1.4426950408889634f);
            l *= sc;
#pragma unroll
            for (int i = 0; i < 16; ++i) { o0[i] *= sc; o1[i] *= sc; }
            m = mn;
        }
        mnl = m * 1.4426950408889634f;
    }
    float ps = 0.f;
#pragma unroll
    for (int i = 0; i < 16; ++i) { const float pv = __builtin_amdgcn_exp2f(xs[i] * 1.4426950408889634f - mnl); xs[i] = pv; ps += pv; }
    l += ps;
#pragma unroll
    for (int s = 0; s < 2; ++s) {
        u32x4 pw; pw.x = cvtpk_s(xs[8 * s], xs[8 * s + 1]); pw.y = cvtpk_s(xs[8 * s + 2], xs[8 * s + 3]); pw.z = cvtpk_s(xs[8 * s + 4], xs[8 * s + 5]); pw.w = cvtpk_s(xs[8 * s + 6], xs[8 * s + 7]);
        const bf16x8 pf = __builtin_bit_cast(bf16x8, pw);
#pragma unroll
        for (int db = 0; db < 2; ++db) {
            LAS unsigned char* va = vbase + troff + 16 * s * KVS + 64 * db;
            const s16x4 v0 = vtr(va), v1 = vtr(va + 8 * KVS);
            bf16x8 vf; vf[0] = v0[0]; vf[1] = v0[1]; vf[2] = v0[2]; vf[3] = v0[3]; vf[4] = v1[0]; vf[5] = v1[1]; vf[6] = v1[2]; vf[7] = v1[3];
            if (db == 0) o0 = __builtin_amdgcn_mfma_f32_32x32x16_bf16(vf, pf, o0, 0, 0, 0); else o1 = __builtin_amdgcn_mfma_f32_32x32x16_bf16(vf, pf, o1, 0, 0, 0);
        }
    }
}

__device__ __forceinline__ void attn_kv_load(u32x4 (&pre)[9], const bf16_t* KB, const bf16_t* VB, int unit, int tid) {
    const int hk = unit & 3, n = (unit >> 2) & 31, b = unit >> 7, t0 = n * 128 - 128;
#pragma unroll
    for (int j = 0; j < 8; ++j) {
        const int pc = tid + j * 512, isv = pc >> 11, q = pc & 2047, kj = q >> 3, ch = q & 7, tk = t0 + kj;
        pre[j] = (u32x4){0u, 0u, 0u, 0u};
        if (tk >= 0) pre[j] = *(const u32x4*)((isv ? VB : KB) + (size_t)(b * SEQ + tk) * 256 + hk * 64 + ch * 8);
    }
    { const int isv = tid >> 8, q = tid & 255, kj = q >> 3, ch = q & 7; pre[8] = (u32x4){0u, 0u, 0u, 0u};
      if (kj < 16) pre[8] = *(const u32x4*)((isv ? VB : KB) + (size_t)(MR + kj) * 256 + hk * 64 + ch * 8); }
}
__device__ __forceinline__ void attn_kv_store(const u32x4 (&pre)[9], LAS unsigned char* lds, int tid) {
#pragma unroll
    for (int j = 0; j < 8; ++j) { const int pc = tid + j * 512, isv = pc >> 11, q = pc & 2047, kj = q >> 3, ch = q & 7; *(LAS u32x4*)(lds + (isv ? AT_VB : AT_KB) + kj * KVS + ch * 16) = pre[j]; }
    { const int isv = tid >> 8, q = tid & 255, kj = q >> 3, ch = q & 7; *(LAS u32x4*)(lds + (isv ? AT_VM : AT_KM) + kj * KVS + ch * 16) = pre[8]; }
}

template <bool BOUNDED>
__device__ __forceinline__ void attn_units(LAS unsigned char* lds, const bf16_t* QB, const bf16_t* KB, const bf16_t* VB, bf16_t* OB, const float* sinks, float bound, int G, int wg) {
    const int tid = threadIdx.x, lane = tid & 63, wave = __builtin_amdgcn_readfirstlane(tid >> 6), r = lane & 31, h = lane >> 5;
    LAS unsigned char* Kb = lds + AT_KB; LAS unsigned char* Vb = lds + AT_VB; LAS unsigned char* Km = lds + AT_KM; LAS unsigned char* Vm = lds + AT_VM;
    const int troff = ((lane & 15) >> 2) * KVS + (16 * ((lane >> 4) & 1) + 4 * (lane & 3)) * 2 + 4 * h * KVS;
    f32x16 zero16;
#pragma unroll
    for (int i = 0; i < 16; ++i) zero16[i] = 0.f;
    constexpr int NU = NB * 32 * NKVH;
    u32x4 pre[9];
    if (wg < NU) attn_kv_load(pre, KB, VB, wg, tid);
    for (int unit = wg; unit < NU; unit += G) {
        const int hk = unit & 3, n = (unit >> 2) & 31, b = unit >> 7;
        __syncthreads();
        attn_kv_store(pre, lds, tid);
        __syncthreads();
        if (unit + G < NU) attn_kv_load(pre, KB, VB, unit + G, tid);
        const int hq = hk * 4 + (wave >> 1);
        const float sink = sinks[hq];
#pragma unroll 1
        for (int qb = 0; qb < 2; ++qb) {
            const int r0 = (wave & 1) * 64 + qb * 32;
            const size_t qrow = (size_t)b * SEQ + n * 128 + r0 + r;
            bf16x8 bq[4];
#pragma unroll
            for (int kd = 0; kd < 4; ++kd) bq[kd] = *(const bf16x8*)(QB + qrow * DM + hq * 64 + 16 * kd + 8 * h);
            f32x16 o0 = zero16, o1 = zero16;
            float m, l;
            if (BOUNDED) { m = fmaxf(bound, sink); l = (h == 0) ? __builtin_amdgcn_exp2f((sink - m) * 1.4426950408889634f) : 0.f; }
            else { m = sink; l = (h == 0) ? 1.f : 0.f; }
            const int kt_lo = (n == 0 && (r0 >> 5) < 4) ? 4 : (r0 >> 5), kt_hi = (r0 >> 5) + 4;
#pragma unroll 1
            for (int tt = kt_lo - 1; tt <= kt_hi; ++tt) {
                const bool ism = (tt == kt_lo - 1);
                LAS unsigned char* kbase = ism ? Km : Kb + tt * 32 * KVS;
                LAS unsigned char* vbase = ism ? Vm : Vb + tt * 32 * KVS;
                int lo = -1, hi = 99;
                if (ism) hi = 15; else if (tt == (r0 >> 5)) lo = r; else if (tt == kt_hi) hi = r;
                const bool masked = ism || (tt == (r0 >> 5)) || (tt == kt_hi);
                attn_tile<BOUNDED>(kbase, vbase, bq, zero16, o0, o1, m, l, r, h, troff, masked, lo, hi);
            }
            l += __shfl_xor(l, 32);
            const float il = 1.f / l;
            bf16_t* op = OB + qrow * DM + hq * 64 + 4 * h;
#pragma unroll
            for (int gi = 0; gi < 4; ++gi) {
                u32x2 w0, w1;
                w0.x = cvtpk_s(o0[4 * gi] * il, o0[4 * gi + 1] * il); w0.y = cvtpk_s(o0[4 * gi + 2] * il, o0[4 * gi + 3] * il);
                w1.x = cvtpk_s(o1[4 * gi] * il, o1[4 * gi + 1] * il); w1.y = cvtpk_s(o1[4 * gi + 2] * il, o1[4 * gi + 3] * il);
                *(u32x2*)(op + 8 * gi) = w0; *(u32x2*)(op + 32 + 8 * gi) = w1;
            }
        }
    }
    __syncthreads();
}

__device__ __forceinline__ void attn_phase(LAS unsigned char* lds, const bf16_t* QB, const bf16_t* KB, const bf16_t* VB, bf16_t* OB, const float* sinks, const float* q_gain, const float* k_gain, int G, int wg) {
    const int lane = threadIdx.x & 63;
    float gq = fabsf(q_gain[lane]), gk = fabsf(k_gain[lane]);
#pragma unroll
    for (int o = 1; o < 64; o <<= 1) { gq = fmaxf(gq, __shfl_xor(gq, o)); gk = fmaxf(gk, __shfl_xor(gk, o)); }
    const float bound = 8.0f * gq * gk * 1.03f + 0.05f;
    if (bound < 30.0f) attn_units<true>(lds, QB, KB, VB, OB, sinks, bound, G, wg);
    else attn_units<false>(lds, QB, KB, VB, OB, sinks, bound, G, wg);
}

#define XB_TMO      128
#define XB_XCNT(j)  (256  + 64 * (j))
#define XB_XSUB(j)  (1280 + 64 * (j))
#define XB_XGEN(j)  (2304 + 64 * (j))
#define XB_TOP      3328
#define XB_TOPGEN   3392
#define XCD_BAR_WORDS 3456
#define XB_SPIN_CAP (1u << 18)

__device__ __forceinline__ unsigned xb_ld(unsigned* p)              { return __hip_atomic_load(p, __ATOMIC_RELAXED, __HIP_MEMORY_SCOPE_AGENT); }
__device__ __forceinline__ unsigned xb_add(unsigned* p, unsigned v) { return __hip_atomic_fetch_add(p, v, __ATOMIC_RELAXED, __HIP_MEMORY_SCOPE_AGENT); }
__device__ __forceinline__ unsigned xb_xcc_id() { return (unsigned)__builtin_amdgcn_s_getreg((3 << 11) | 20) & 0xFu; }
#define XB_SPIN(cond, bar) do { unsigned _sp = 0; while (cond) { __builtin_amdgcn_s_sleep(1); \
    if ((++_sp & 255u) == 0u) { if (xb_ld(&(bar)[XB_TMO])) break; if (_sp > XB_SPIN_CAP) { atomicAdd(&(bar)[XB_TMO], 1u); break; } } } } while (0)

struct XcdBarrier {
    unsigned* bar; unsigned x;
    volatile LAS unsigned* st;
};

__device__ __forceinline__ XcdBarrier xcd_barrier_post(unsigned* bar, volatile LAS unsigned* st) {
    XcdBarrier b; b.bar = bar; b.x = xb_xcc_id(); b.st = st;
    if (threadIdx.x == 0) (void)xb_add(&bar[XB_XCNT(b.x)], 1u);
    return b;
}
__device__ __forceinline__ void xcd_barrier_complete(unsigned* bar, unsigned x, unsigned& nloc, unsigned& nx) {
    const unsigned G = gridDim.x * gridDim.y * gridDim.z;
    unsigned sum, cnt, mine, sp = 0u;
    for (;;) {
        sum = 0u; cnt = 0u; mine = 0u;
#pragma unroll
        for (unsigned j = 0; j < 16; ++j) { const unsigned c = xb_ld(&bar[XB_XCNT(j)]); sum += c; cnt += (c > 0u) ? 1u : 0u; mine = (j == x) ? c : mine; }
        if (sum == G) break;
        __builtin_amdgcn_s_sleep(1);
        if ((++sp & 255u) == 0u) { if (xb_ld(&bar[XB_TMO])) break; if (sp > XB_SPIN_CAP) { atomicAdd(&bar[XB_TMO], 1u); break; } }
    }
    nloc = mine > 0u ? mine : 1u; nx = cnt > 0u ? cnt : 1u;
}

__device__ __forceinline__ void xcd_barrier(const XcdBarrier& b) {
    asm volatile("s_waitcnt vmcnt(0)" ::: "memory");
    __syncthreads();
    if (threadIdx.x == 0) {
        unsigned* bar = b.bar;
        __builtin_amdgcn_s_waitcnt(0);
        unsigned nloc = b.st[0], nx = b.st[1];
        if (nloc == 0u) { xcd_barrier_complete(bar, b.x, nloc, nx); b.st[0] = nloc; b.st[1] = nx; }
        const unsigned old = xb_add(&bar[XB_XSUB(b.x)], 1u);
        const unsigned gen = old / nloc;
        if (old + 1u == (gen + 1u) * nloc) {
            __builtin_amdgcn_fence(__ATOMIC_RELEASE, "agent");
            asm volatile("s_waitcnt vmcnt(0)" ::: "memory");
            const unsigned og = xb_add(&bar[XB_TOP], 1u);
            const unsigned tg = og / nx;
            if (og + 1u == (tg + 1u) * nx) xb_add(&bar[XB_TOPGEN], 1u);
            else XB_SPIN(xb_ld(&bar[XB_TOPGEN]) == tg, bar);
            __builtin_amdgcn_fence(__ATOMIC_ACQUIRE, "agent");
            xb_add(&bar[XB_XGEN(b.x)], 1u);
            asm volatile("s_waitcnt vmcnt(0)" ::: "memory");
        } else {
            XB_SPIN(xb_ld(&bar[XB_XGEN(b.x)]) == gen, bar);
            __builtin_amdgcn_fence(__ATOMIC_ACQUIRE, "agent");
            asm volatile("s_waitcnt vmcnt(0)" ::: "memory");
        }
    }
    __syncthreads();
}


constexpr int NPH = 17;
struct KArgs { Params p; int ph_lo, ph_hi; };

__global__ void __launch_bounds__(512, 2) yoco_fwd(KArgs ka) {
    extern __shared__ __attribute__((aligned(16))) unsigned char lds_raw[];
    LAS unsigned char* lds = (LAS unsigned char*)lds_raw;
    cg::grid_group grid = cg::this_grid();
    const Params& p = ka.p;
    const int tid = threadIdx.x, lane = tid & 63, wave = __builtin_amdgcn_readfirstlane(tid >> 6);
    const int G = gridDim.x, wg = blockIdx.x;
    const int gtid = wg * 512 + tid, gthreads = G * 512;
    const int gwave = wg * 8 + wave, gwaves = G * 8;
    const int swave = wave * G + wg;
    unsigned char* ws = p.ws;
    volatile LAS unsigned* MISC = (volatile LAS unsigned*)(lds + LDS_STAGE + 1024);
    if (tid < 16) MISC[tid] = 0u;
    __syncthreads();
    XcdBarrier xbar = xcd_barrier_post((unsigned*)ws, MISC + 8);
    const float* x = p.in[0]; const float* meta = p.in[1];
    const float* ffn1_norm = p.in[2]; const float* ffn1_wgu = p.in[3]; const float* ffn1_wd = p.in[4];
    const float* mix_norm = p.in[5]; const float* ffn2_norm = p.in[6]; const float* ffn2_wgu = p.in[7]; const float* ffn2_wd = p.in[8];
    const float* ssm_w_in = p.in[9]; const float* lam_re = p.in[10]; const float* lam_im = p.in[11];
    const float* b_re = p.in[12]; const float* b_im = p.in[13]; const float* c_re = p.in[14]; const float* c_im = p.in[15];
    const float* log_step = p.in[16]; const float* ssm_d = p.in[17]; const float* ssm_w_out = p.in[18];
    const float* kv_norm = p.in[19]; const float* w_kv = p.in[20]; const float* k_norm = p.in[21];
    const float* attn_w_q = p.in[22]; const float* q_norm = p.in[23]; const float* sinks = p.in[24]; const float* attn_w_o = p.in[25];
    float* out = p.out;
    bf16_t* WGU = (bf16_t*)(ws + WS_WGU); bf16_t* WD = (bf16_t*)(ws + WS_WD);
    bf16_t* WIN = (bf16_t*)(ws + WS_WIN); bf16_t* WOUT = (bf16_t*)(ws + WS_WOUT); bf16_t* WKV = (bf16_t*)(ws + WS_WKV);
    bf16_t* WQ = (bf16_t*)(ws + WS_WQ); bf16_t* WO = (bf16_t*)(ws + WS_WO);
    float* ROPE = (float*)(ws + WS_ROPE); float* SSQ = (float*)(ws + WS_SSQ); float* HMETA = (float*)(ws + WS_HMETA);
    bf16_t* HB = (bf16_t*)(ws + WS_HB); bf16_t* KB = (bf16_t*)(ws + WS_KB); bf16_t* VB = (bf16_t*)(ws + WS_VB);
    bf16_t* ACT = (bf16_t*)(ws + WS_ACT); bf16_t* UG = (bf16_t*)(ws + WS_UG); bf16_t* YB = (bf16_t*)(ws + WS_YB);
    float* UMETA = (float*)(ws + WS_UMETA); float* SMETA = (float*)(ws + WS_SMETA); float* SLOC = (float*)(ws + WS_SLOC);
    bf16_t* KMAT = (bf16_t*)(ws + WS_KMAT); bf16_t* MEND = (bf16_t*)(ws + WS_MEND);
    float* KD = (float*)(ws + WS_KD); float* APOW = (float*)(ws + WS_APOW); float* BBAR = (float*)(ws + WS_BBAR);
    bf16_t* QB = (bf16_t*)(ws + WS_QB); bf16_t* OB = (bf16_t*)(ws + WS_OB);
    const size_t EGU = (size_t)2 * FF * DM, EWD = (size_t)DM * FF;

    const int lo = ka.ph_lo, hi = ka.ph_hi;
#define IN(k) (lo <= (k) && (k) < hi)
#define SEAM(k) do { if (IN(k) && IN((k) + 1)) { if (lo < 0) grid.sync(); else xcd_barrier(xbar); } } while (0)

    if (IN(0)) {
        LAS float* scr = (LAS float*)lds;
        for (int l = 0; l < 2; ++l) {
            conv_wT(scr, ffn1_wgu + l * EGU, DM, 2 * FF, ffn1_norm + l * DM, WGU + (2 * l) * EGU, 2 * FF, 1, G, wg);
            conv_wT(scr, ffn2_wgu + l * EGU, DM, 2 * FF, ffn2_norm + l * DM, WGU + (2 * l + 1) * EGU, 2 * FF, 1, G, wg);
            conv_wT(scr, ffn1_wd + l * EWD, FF, DM, nullptr, WD + (2 * l) * EWD, DM, 0, G, wg, true);
            conv_wT(scr, ffn2_wd + l * EWD, FF, DM, nullptr, WD + (2 * l + 1) * EWD, DM, 0, G, wg, true);
        }
        conv_wT(scr, ssm_w_in, DM, SW, mix_norm, WIN, SW, 0, G, wg);
        conv_wT(scr, ssm_w_out, SW, 2 * DM, nullptr, WOUT, 2 * DM, 2, G, wg);
        conv_wT(scr, w_kv, DM, 512, kv_norm, WKV, 512, 3, G, wg);
        conv_wT(scr, attn_w_q, DM, DM, mix_norm + DM, WQ, DM, 3, G, wg);
        conv_wT(scr, attn_w_o, DM, DM, nullptr, WO, DM, 0, G, wg);
        for (int i = gtid; i < LSEQ * 32; i += gthreads) {
            const int pos = i >> 5, d = i & 31;
            const double fr = exp(-(double)d * (2.0 / HD) * 9.210340371976184);
            const double ang = (double)pos * fr;
            ROPE[2 * i] = (float)cos(ang); ROPE[2 * i + 1] = (float)sin(ang);
        }
        for (int item = wg; item < SG * 65; item += G) {
            const int g = item / 65, d = item % 65;
            LAS float* apd = (LAS float*)lds;
            LAS float* bbl = apd + 128;
            __syncthreads();
            if (tid < 64) {
                const float lr = lam_re[g * SP + tid], li = lam_im[g * SP + tid], st = expf(log_step[g]);
                const float mg = expf((float)d * lr * st), ang = (float)d * (li * st);
                const float pr = mg * cosf(ang), pi = mg * sinf(ang);
                apd[2 * tid] = pr; apd[2 * tid + 1] = pi;
                APOW[((size_t)(g * 65 + d) * 64 + tid) * 2] = pr; APOW[((size_t)(g * 65 + d) * 64 + tid) * 2 + 1] = pi;
            }
            for (int e = tid; e < 1024; e += 512) {
                const int pp = e >> 4;
                const float lr = lam_re[g * SP + pp], li = lam_im[g * SP + pp], st = expf(log_step[g]);
                const float mg = expf(lr * st), ar = mg * cosf(li * st), ai = mg * sinf(li * st);
                const float den = lr * lr + li * li, nr = ar - 1.0f, ni = ai;
                const float cr = (nr * lr + ni * li) / den, ci = (ni * lr - nr * li) / den;
                const float br = b_re[(size_t)g * 1024 + e], bi = b_im[(size_t)g * 1024 + e];
                const float vr = cr * br - ci * bi, vi = cr * bi + ci * br;
                bbl[2 * e] = vr; bbl[2 * e + 1] = vi;
                if (d == 0) { BBAR[((size_t)g * 1024 + e) * 2] = vr; BBAR[((size_t)g * 1024 + e) * 2 + 1] = vi; }
            }
            __syncthreads();
            if (d < 64 && tid < 256) {
                const int cp = tid >> 4, c = tid & 15;
                float s = 0.f;
                for (int pp = 0; pp < 64; ++pp) {
                    const float Cr = c_re[(g * SC + cp) * SP + pp], Ci = c_im[(g * SC + cp) * SP + pp];
                    const float pr = apd[2 * pp], pi = apd[2 * pp + 1];
                    const float wr_ = Cr * pr - Ci * pi, wi_ = Cr * pi + Ci * pr;
                    s += wr_ * bbl[2 * (pp * 16 + c)] - wi_ * bbl[2 * (pp * 16 + c) + 1];
                }
                if (d == 0 && c == cp) s += ssm_d[g * SC + cp];
                KD[(size_t)(g * 64 + d) * 256 + tid] = s;
            }
        }
        __syncthreads();
        for (int i = gtid; i < 5 * MT; i += gthreads) SSQ[MT + i] = 0.f;
        for (int row = gwave; row < MT; row += gwaves) {
            const float* src = row < MR ? x + (size_t)row * DM : (row < MR + NMETA ? meta + (size_t)(row - MR) * DM : nullptr);
            float ss = 0.f;
#pragma unroll
            for (int s = 0; s < 2; ++s) {
                const int c = s * 512 + lane * 8;
                f32x4 a = (f32x4){0.f, 0.f, 0.f, 0.f}, b = a;
                if (src) { a = __builtin_nontemporal_load((const f32x4*)(src + c)); b = __builtin_nontemporal_load((const f32x4*)(src + c + 4)); }
                ss += a[0] * a[0] + a[1] * a[1] + a[2] * a[2] + a[3] * a[3] + b[0] * b[0] + b[1] * b[1] + b[2] * b[2] + b[3] * b[3];
                *(u32x4*)(HB + (size_t)row * DM + c) = pack8(a, b);
            }
#pragma unroll
            for (int o = 1; o < 64; o <<= 1) ss += __shfl_xor(ss, o);
            if (lane == 0) SSQ[row] = ss;
        }
    }
    SEAM(0);
    if (IN(1)) {
        pg8::Gemm g{HB, WGU + 0 * EGU, DM, DM, DM}; pg8::StaticOrder S; S.init(MR, 2 * FF, G, wg);
        EpiSwiglu E{ACT, SSQ + 0 * MT};
        pg8::gemm_phase(lds, g, S, E);
        for (int it = wg; it < FF / 16; it += G) sk_swiglu(it, HB, WGU + 0 * EGU, ACT, SSQ + 0 * MT, lane, wave, lds);
    }
    SEAM(1);
    if (IN(2)) {
        pg8::Gemm g{ACT, WD + 0 * EWD, 64, 64, FF, 256 * 64 * 2, (long)ACT_KT * 256 * 64 * 2, 256 * 64 * 2, (long)ACT_KT * 256 * 64 * 2}; pg8::StaticOrder S; S.init(MR, DM, G, wg);
        EpiRes<0> E{x, meta, out, HB, SSQ + 1 * MT, 0.5f};
        pg8::gemm_phase(lds, g, S, E);
        for (int it = wg; it < DM / 16; it += G) sk_down(it, ACT, WD + 0 * EWD, HB, meta, SSQ + 1 * MT, lane, wave, lds);
    }
    SEAM(2);
    if (IN(3)) {
        pg8::Gemm g{HB, WIN, DM, DM, DM}; pg8::StaticOrder S; S.init(MR, SW, G, wg);
        EpiWin E{UG, UMETA, SSQ + 1 * MT};
        pg8::gemm_phase(lds, g, S, E);
        for (int it = wg; it < SW / 16; it += G) sk_win(it, HB, WIN, UMETA, SSQ + 1 * MT, lane, wave, lds);
    }
    if (IN(3)) {
        for (int it0 = gtid; it0 < SG * 1024 * 128; it0 += 4 * gthreads) {
            f32x4 v0[4], v1[4]; size_t dst[4]; bool ok[4], nz[4];
#pragma unroll
            for (int q = 0; q < 4; ++q) {
                const int it = it0 + q * gthreads; ok[q] = it < SG * 1024 * 128;
                const int itc = ok[q] ? it : 0, kq = itc & 127, n = (itc >> 7) & 1023, g = itc >> 17, t = n >> 4, cp = n & 15, k0 = kq * 8, s = k0 >> 4, c0 = k0 & 15;
                nz[q] = t >= s; const int d = nz[q] ? t - s : 0;
                const float* kp = KD + (size_t)(g * 64 + d) * 256 + cp * 16 + c0; v0[q] = *(const f32x4*)kp; v1[q] = *(const f32x4*)(kp + 4);
                dst[q] = (size_t)(g * 1024 + n) * KC + kq * 8;
            }
#pragma unroll
            for (int q = 0; q < 4; ++q) if (ok[q]) { const f32x4 z = (f32x4){0.f, 0.f, 0.f, 0.f}; *(u32x4*)(KMAT + dst[q]) = pack8(nz[q] ? v0[q] : z, nz[q] ? v1[q] : z); }
        }
        for (int it = gtid; it < SG * 1024 * 16; it += gthreads) {
            const int kq = 128 + (it & 15), n = (it >> 4) & 1023, g = it >> 14, t = n >> 4, cp = n & 15;
            f32x4 v0, v1;
            const int j0 = (kq - 128) * 8, im = j0 >> 6, p0 = j0 & 63;
#pragma unroll
            for (int e = 0; e < 8; ++e) {
                const int pp = p0 + e;
                const float Cr = c_re[(g * SC + cp) * SP + pp], Ci = c_im[(g * SC + cp) * SP + pp];
                const float pr = APOW[((size_t)(g * 65 + t + 1) * 64 + pp) * 2], pi = APOW[((size_t)(g * 65 + t + 1) * 64 + pp) * 2 + 1];
                const float val = im ? -(Cr * pi + Ci * pr) : (Cr * pr - Ci * pi);
                if (e < 4) v0[e] = val; else v1[e - 4] = val;
            }
            *(u32x4*)(KMAT + ((size_t)(g * 1024 + n) * KC + kq * 8)) = pack8(v0, v1);
        }
        for (int it = gtid; it < SG * 256 * 128; it += gthreads) {
            const int kq = it & 127, n = (it >> 7) & 255, g = it >> 15;
            f32x4 v0 = (f32x4){0.f, 0.f, 0.f, 0.f}, v1 = v0;
            if (n < 128) {
                const int im = n >> 6, pp = n & 63, k0 = kq * 8, s = k0 >> 4, c0 = k0 & 15;
                const float pr = APOW[((size_t)(g * 65 + 63 - s) * 64 + pp) * 2], pi = APOW[((size_t)(g * 65 + 63 - s) * 64 + pp) * 2 + 1];
#pragma unroll
                for (int e = 0; e < 8; ++e) {
                    const float br = BBAR[((size_t)(g * 64 + pp) * 16 + c0 + e) * 2], bi = BBAR[((size_t)(g * 64 + pp) * 16 + c0 + e) * 2 + 1];
                    const float val = im ? (pr * bi + pi * br) : (pr * br - pi * bi);
                    if (e < 4) v0[e] = val; else v1[e - 4] = val;
                }
            }
            *(u32x4*)(MEND + ((size_t)(g * 256 + n) * 1024 + kq * 8)) = pack8(v0, v1);
        }
    }
    SEAM(3);
    if (IN(4)) {
        pg8::Gemm gm{UG, MEND, KC, 1024, 1024}; pg8::BatchOrder S; S.init(SG, 4, 1, G, wg);
        EpiSloc E{SLOC};
        pg8::gemm_phase(lds, gm, S, E);
        Unit uu;
        for (int i = 0; S.next(i, uu); ++i) {
            const int g = uu.pn, pm4 = uu.pm & 3;
            LAS float* sm = (LAS float*)lds;
            __syncthreads();
            if (wave == 0) {
                const int pp = lane;
                const float ar = APOW[((size_t)(g * 65 + 1) * 64 + pp) * 2], ai = APOW[((size_t)(g * 65 + 1) * 64 + pp) * 2 + 1];
                float bbr[16], bbi[16], ccr[16], cci[16];
#pragma unroll
                for (int c = 0; c < 16; ++c) {
                    bbr[c] = BBAR[((size_t)(g * 64 + pp) * 16 + c) * 2]; bbi[c] = BBAR[((size_t)(g * 64 + pp) * 16 + c) * 2 + 1];
                    ccr[c] = c_re[(g * SC + c) * SP + pp]; cci[c] = c_im[(g * SC + c) * SP + pp];
                }
                const float dsk = ssm_d[g * SC + (lane & 15)];
                float xr = 0.f, xi = 0.f;
                for (int t = 0; t < NMETA; ++t) {
                    float uv[16];
                    const float* up = UMETA + (size_t)t * SW + g * SC;
#pragma unroll
                    for (int c = 0; c < 16; ++c) uv[c] = up[c];
                    float bur = 0.f, bui = 0.f;
#pragma unroll
                    for (int c = 0; c < 16; ++c) { bur += bbr[c] * uv[c]; bui += bbi[c] * uv[c]; }
                    const float nxr = ar * xr - ai * xi + bur, nxi = ar * xi + ai * xr + bui;
                    xr = nxr; xi = nxi;
                    if (pm4 == 0) {
                        float mine = 0.f;
#pragma unroll
                        for (int c = 0; c < 16; ++c) {
                            float z = ccr[c] * xr - cci[c] * xi;
#pragma unroll
                            for (int o = 1; o < 64; o <<= 1) z += __shfl_xor(z, o);
                            if ((lane & 15) == c) mine = z + dsk * uv[c];
                        }
                        if (lane < 16) YB[(size_t)(MR + t) * SW + g * SC + lane] = f2bf(gelu_tanh(mine));
                    }
                }
                sm[pp] = xr; sm[64 + pp] = xi;
            }
            __syncthreads();
            if (tid < 256) {
                const int pp = tid & 63, b = pm4 * 4 + (tid >> 6);
                const float ar = APOW[((size_t)(g * 65 + 64) * 64 + pp) * 2], ai = APOW[((size_t)(g * 65 + 64) * 64 + pp) * 2 + 1];
                float xr = sm[pp], xi = sm[64 + pp];
#pragma unroll 8
                for (int c = 0; c < 64; ++c) {
                    const size_t row = (size_t)g * 1024 + b * 64 + c;
                    const float sr = SLOC[row * 128 + pp], si = SLOC[row * 128 + 64 + pp];
                    UG[row * KC + 1024 + pp] = f2bf(xr); UG[row * KC + 1088 + pp] = f2bf(xi);
                    const float nxr = ar * xr - ai * xi + sr, nxi = ar * xi + ai * xr + si;
                    xr = nxr; xi = nxi;
                }
            }
        }
    }
    SEAM(5);
    if (IN(6)) {
        pg8::Gemm g{UG, KMAT, KC, KC, KC}; pg8::BatchOrder S; S.init(SG, 4, 4, G, wg);
        EpiY E{YB};
        pg8::gemm_phase(lds, g, S, E);
    }
    SEAM(6);
    if (IN(7)) {
        pg8::Gemm g{YB, WOUT, SW, SW, SW}; pg8::StaticOrder S; S.init(MR, 2 * DM, G, wg);
        EpiGlu E{HB, SSQ + 2 * MT};
        pg8::gemm_phase(lds, g, S, E);
        for (int it = wg; it < DM / 16; it += G) sk_glu(it, YB, WOUT, HB, SSQ + 2 * MT, lane, wave, lds);
    }
    SEAM(7);
    if (IN(8)) {
        pg8::Gemm g{HB, WGU + 1 * EGU, DM, DM, DM}; pg8::StaticOrder S; S.init(MR, 2 * FF, G, wg);
        EpiSwiglu E{ACT, SSQ + 2 * MT};
        pg8::gemm_phase(lds, g, S, E);
        for (int it = wg; it < FF / 16; it += G) sk_swiglu(it, HB, WGU + 1 * EGU, ACT, SSQ + 2 * MT, lane, wave, lds);
    }
    SEAM(8);
    if (IN(9)) {
        pg8::Gemm g{ACT, WD + 1 * EWD, 64, 64, FF, 256 * 64 * 2, (long)ACT_KT * 256 * 64 * 2, 256 * 64 * 2, (long)ACT_KT * 256 * 64 * 2}; pg8::StaticOrder S; S.init(MR, DM, G, wg);
        EpiRes<1> E{x, meta, out, HB, SSQ + 3 * MT, 0.5f};
        pg8::gemm_phase(lds, g, S, E);
        for (int it = wg; it < DM / 16; it += G) sk_down(it, ACT, WD + 1 * EWD, HB, nullptr, SSQ + 3 * MT, lane, wave, lds);
    }
    SEAM(9);
    if (IN(10)) {
        { pg8::Gemm g{HB, WKV, DM, DM, DM}; pg8::StaticOrder S; S.init(MR, 512, G, wg);
          EpiHead<false> E{KB, VB, SSQ + 3 * MT, k_norm, ROPE, 1.0f};
          pg8::gemm_phase(lds, g, S, E); }
        for (int it = wg; it < 8; it += G) sk_kv(it, HB, WKV, KB, VB, SSQ + 3 * MT, k_norm, ROPE, lane, wave, lds);
        __syncthreads();
        { pg8::Gemm g{HB, WGU + 2 * EGU, DM, DM, DM}; pg8::StaticOrder S; S.init(MR, 2 * FF, G, wg);
          EpiSwiglu E{ACT, SSQ + 3 * MT};
          pg8::gemm_phase(lds, g, S, E); }
    }
    SEAM(10);
    if (IN(11)) {
        pg8::Gemm g{ACT, WD + 2 * EWD, 64, 64, FF, 256 * 64 * 2, (long)ACT_KT * 256 * 64 * 2, 256 * 64 * 2, (long)ACT_KT * 256 * 64 * 2}; pg8::StaticOrder S; S.init(MR, DM, G, wg);
        EpiRes<1> E{x, meta, out, HB, SSQ + 4 * MT, 0.5f};
        pg8::gemm_phase(lds, g, S, E);
    }
    SEAM(11);
    if (IN(12)) {
        pg8::Gemm g{HB, WQ, DM, DM, DM}; pg8::StaticOrder S; S.init(MR, DM, G, wg);
        EpiHead<true> E{QB, QB, SSQ + 4 * MT, q_norm, ROPE, 0.125f};
        pg8::gemm_phase(lds, g, S, E);
    }
    SEAM(12);
    if (IN(13)) attn_phase(lds, QB, KB, VB, OB, sinks, q_norm, k_norm, G, wg);
    SEAM(13);
    if (IN(14)) {
        pg8::Gemm g{OB, WO, DM, DM, DM}; pg8::StaticOrder S; S.init(MR, DM, G, wg);
        EpiRes<1> E{x, meta, out, HB, SSQ + 5 * MT, 1.0f};
        pg8::gemm_phase(lds, g, S, E);
    }
    SEAM(14);
    if (IN(15)) {
        pg8::Gemm g{HB, WGU + 3 * EGU, DM, DM, DM}; pg8::StaticOrder S; S.init(MR, 2 * FF, G, wg);
        EpiSwiglu E{ACT, SSQ + 5 * MT};
        pg8::gemm_phase(lds, g, S, E);
    }
    SEAM(15);
    if (IN(16)) {
        pg8::Gemm g{ACT, WD + 3 * EWD, 64, 64, FF, 256 * 64 * 2, (long)ACT_KT * 256 * 64 * 2, 256 * 64 * 2, (long)ACT_KT * 256 * 64 * 2}; pg8::StaticOrder S; S.init(MR, DM, G, wg);
        EpiRes<2> E{x, meta, out, HB, SSQ, 0.5f};
        pg8::gemm_phase(lds, g, S, E);
    }
#undef IN
#undef SEAM
}

extern "C" void kernel_launch(void* const* d_in, const int* in_sizes, int n_in, void* d_out, int out_size, void* d_ws, size_t ws_size, hipStream_t stream) {
    static int grid = 0;
    if (grid == 0) {
        if (n_in != 26 || ws_size < WS_END) { fprintf(stderr, "kernel_launch: unexpected n_in %d / ws %zu (need %zu)\n", n_in, ws_size, (size_t)WS_END); grid = -1; return; }
        int dev = 0, cus = 0, per_cu = 0;
        hipGetDevice(&dev);
        hipDeviceGetAttribute(&cus, hipDeviceAttributeMultiprocessorCount, dev);
        if (hipFuncSetAttribute((const void*)yoco_fwd, hipFuncAttributeMaxDynamicSharedMemorySize, LDS_BYTES) != hipSuccess) { fprintf(stderr, "kernel_launch: hipFuncSetAttribute failed\n"); grid = -1; return; }
        hipOccupancyMaxActiveBlocksPerMultiprocessor(&per_cu, (const void*)yoco_fwd, 512, LDS_BYTES);
        if (per_cu < 1) { fprintf(stderr, "kernel_launch: occupancy query says %d blocks/CU\n", per_cu); per_cu = 1; }
        (void)hipGetLastError();
        grid = cus * 1;
    }
    if (grid < 0) return;
    KArgs ka{};
    for (int i = 0; i < 26; ++i) ka.p.in[i] = (const float*)d_in[i];
    ka.p.out = (float*)d_out; ka.p.ws = (unsigned char*)d_ws;
    ka.ph_lo = 0; ka.ph_hi = NPH;
    if (hipMemsetAsync(d_ws, 0, 65536, stream) != hipSuccess) { fprintf(stderr, "memset failed\n"); return; }
    void* args[] = {&ka};
    hipError_t e = hipLaunchCooperativeKernel((const void*)yoco_fwd, dim3(grid), dim3(512), args, LDS_BYTES, stream);
    if (e != hipSuccess) fprintf(stderr, "cooperative launch failed: %s (grid %d)\n", hipGetErrorString(e), grid);
}
```

```cpp
#include <hip/hip_runtime.h>
#include <hip/hip_cooperative_groups.h>
#include <cstdio>
#include <cstdint>
namespace cg = cooperative_groups;

#define LAS __attribute__((address_space(3)))
typedef unsigned short bf16_t;
typedef short bf16x8 __attribute__((ext_vector_type(8)));
typedef float f32x4 __attribute__((ext_vector_type(4)));
typedef float f32x2 __attribute__((ext_vector_type(2)));
typedef unsigned u32x4 __attribute__((ext_vector_type(4)));
typedef unsigned u32x2 __attribute__((ext_vector_type(2)));

constexpr int DM = 1024, NB = 16, SEQ = 4096, NMETA = 16, FF = 2816, SW = 512, SG = 32, SP = 64, SC = 16, HD = 64, NQH = 16, NKVH = 4;
constexpr int MR = NB * SEQ;
constexpr int MT = MR + 256;
constexpr int LSEQ = SEQ + NMETA;
constexpr float EPS = 1e-6f;
constexpr int KC = 1152;

constexpr size_t al256(size_t x) { return (x + 255) & ~(size_t)255; }
constexpr size_t WS_WGU = 1 << 20;
constexpr size_t SZ_WGU = (size_t)2 * FF * DM * 2;
constexpr size_t WS_WD = WS_WGU + 4 * SZ_WGU;
constexpr size_t SZ_WD = (size_t)DM * FF * 2;
constexpr size_t WS_WIN = WS_WD + 4 * SZ_WD;
constexpr size_t WS_WOUT = WS_WIN + (size_t)SW * DM * 2;
constexpr size_t WS_WKV = WS_WOUT + (size_t)2 * DM * SW * 2;
constexpr size_t WS_WQ = WS_WKV + (size_t)512 * DM * 2;
constexpr size_t WS_WO = WS_WQ + (size_t)DM * DM * 2;
constexpr size_t WS_KMAT = WS_WO + (size_t)DM * DM * 2;
constexpr size_t WS_MEND = WS_KMAT + (size_t)SG * 1024 * KC * 2;
constexpr size_t WS_KD = WS_MEND + (size_t)SG * 256 * 1024 * 2;
constexpr size_t WS_APOW = WS_KD + (size_t)SG * 64 * 256 * 4;
constexpr size_t WS_BBAR = al256(WS_APOW + (size_t)SG * 65 * 64 * 2 * 4);
constexpr size_t WS_ROPE = al256(WS_BBAR + (size_t)SG * 64 * 16 * 2 * 4);
constexpr size_t WS_SSQ = al256(WS_ROPE + (size_t)LSEQ * 32 * 2 * 4);
constexpr size_t WS_HMETA = al256(WS_SSQ + (size_t)6 * MT * 4);
constexpr size_t WS_HB = al256(WS_HMETA + (size_t)256 * DM * 4);
constexpr size_t WS_KB = al256(WS_HB + (size_t)MT * DM * 2);
constexpr size_t WS_VB = al256(WS_KB + (size_t)MT * 256 * 2);
constexpr size_t WS_ACT = al256(WS_VB + (size_t)MT * 256 * 2);
constexpr size_t WS_END = al256(WS_ACT + (size_t)MT * FF * 2);
constexpr size_t WS_UG = WS_ACT;
constexpr size_t WS_YB = WS_ACT + ((size_t)80 << 20);
constexpr size_t WS_SLOC = WS_ACT + ((size_t)160 << 20);
constexpr size_t WS_UMETA = WS_ACT + ((size_t)180 << 20);
constexpr size_t WS_SMETA = WS_UMETA + 65536;
constexpr size_t WS_QB = WS_ACT;
constexpr size_t WS_OB = WS_ACT + (size_t)MR * DM * 2;
static_assert(WS_UG + (size_t)SG * 1024 * KC * 2 <= WS_YB && WS_YB + (size_t)MT * SW * 2 <= WS_SLOC && WS_SLOC + (size_t)SG * 1024 * 128 * 4 <= WS_UMETA && WS_SMETA + 16384 <= WS_END, "ssm overlay");
static_assert(WS_OB + (size_t)MR * DM * 2 <= WS_END && WS_END <= ((size_t)1 << 30), "ws map");

constexpr int LDS_STAGE = 131072;
constexpr int LDS_ROWTBL = LDS_STAGE + 2048;
constexpr int LDS_BYTES = 147456;

__device__ __forceinline__ unsigned cvt_pk_bf16(float lo, float hi) { unsigned r; asm volatile("v_cvt_pk_bf16_f32 %0, %1, %2" : "=v"(r) : "v"(lo), "v"(hi)); return r; }
__device__ __forceinline__ float bf2f(bf16_t b) { return __uint_as_float(((unsigned)b) << 16); }
__device__ __forceinline__ bf16_t f2bf(float f) { return (bf16_t)(cvt_pk_bf16(f, 0.f) & 0xffffu); }
__device__ __forceinline__ u32x4 pack8(f32x4 a, f32x4 b) { u32x4 w; w.x = cvt_pk_bf16(a[0], a[1]); w.y = cvt_pk_bf16(a[2], a[3]); w.z = cvt_pk_bf16(b[0], b[1]); w.w = cvt_pk_bf16(b[2], b[3]); return w; }
__device__ __forceinline__ float fast_sigmoid(float x) { return __builtin_amdgcn_rcpf(1.f + __builtin_amdgcn_exp2f(-1.4426950408889634f * x)); }
__device__ __forceinline__ float gelu_tanh(float y) {
    const float z = 0.7978845608028654f * (y + 0.044715f * y * y * y);
    return y * fast_sigmoid(2.f * z);
}

namespace pg8 {
constexpr int BM = 256, BK = 64, HALF = 128, HTB = HALF * BK * 2, NXCD = 8, WGM = 8;
__host__ __device__ __forceinline__ int lds_byte(int r, int c) { const int st = (r >> 4) * 2 + (c >> 5), rr = r & 15, cc = c & 31, ob = rr * 64 + cc * 2; return st * 1024 + (ob ^ (((ob >> 9) & 1) << 5)); }
__host__ __device__ __forceinline__ void stage_rc(int b, int& R, int& C) { const int st = b / 1024, sb = b % 1024, swz = sb ^ (((sb >> 9) & 1) << 5); R = (st >> 1) * 16 + swz / 64; C = (st & 1) * 32 + (swz % 64) / 2; }
__host__ __device__ __forceinline__ int perm32(int rho) { const int n = rho >> 4, i = rho & 15; return 8 * (i >> 2) + 4 * n + (i & 3); }

struct Unit { int pm, pn; };
struct Gemm { const bf16_t* A; const bf16_t* Bt; int lda, ldb, K; int kstepA = 0; long tstepA_ = 0; };

struct StaticOrder {
    int nM, nN, nwg, G, c;
    __device__ __forceinline__ void init(int M, int N, int G_, int c_) { nM = M / BM; nN = N / BM; nwg = nM * nN; G = G_; c = c_; }
    __device__ __forceinline__ bool next(int i, Unit& u) const {
        const long L = (long)i * G + c; if (L >= nwg) return false;
        int wgid = (int)L; { const int q = nwg / NXCD, r = nwg % NXCD, xcd = wgid % NXCD, off = wgid / NXCD; wgid = (xcd < r ? xcd * (q + 1) : r * (q + 1) + (xcd - r) * q) + off; }
        const int nig = WGM * nN, gid = wgid / nig, fm = gid * WGM, gsz = (nM - fm) < WGM ? (nM - fm) : WGM;
        u.pm = fm + ((wgid % nig) % gsz); u.pn = (wgid % nig) / gsz; return true;
    }
};
struct BatchOrder {
    int nb, nM, nN, G, c;
    __device__ __forceinline__ void init(int nb_, int nM_, int nN_, int G_, int c_) { nb = nb_; nM = nM_; nN = nN_; G = G_; c = c_; }
    __device__ __forceinline__ bool next(int i, Unit& u) const {
        const int L = i * G + c; if (L >= nb * nM * nN) return false;
        const int b = L / (nM * nN), r = L % (nM * nN);
        u.pm = b * nM + r % nM; u.pn = b * nN + r / nM; return true;
    }
};

template <class Epi, class Sched>
__device__ __forceinline__ void gemm_phase(LAS unsigned char* lds, const Gemm g, const Sched& S, const Epi& E) {
    const int tid = threadIdx.x, wid = __builtin_amdgcn_readfirstlane(tid >> 6), lane = tid & 63, wr = wid >> 2, wc = wid & 3, fr = lane & 15, fq = lane >> 4;
    const int K = g.K, nt = K / BK;
    unsigned voffA[2], voffB[2];
#pragma unroll
    for (int i = 0; i < 2; ++i) { int R, C; stage_rc(tid * 16 + i * 8192, R, C); const int Rb = (R & ~31) + perm32(R & 31);
        voffA[i] = (unsigned)(R * g.lda + C) * 2u; voffB[i] = (unsigned)(Rb * g.ldb + C) * 2u; }
    const size_t kstep = (size_t)(BK * 2), kstepA = g.kstepA ? (size_t)g.kstepA : kstep;
    const size_t hstepA = (size_t)HALF * g.lda * 2, hstepB = (size_t)HALF * g.ldb * 2;
    const size_t tstepA = g.tstepA_ ? (size_t)g.tstepA_ : 2 * hstepA, tstepB = 2 * hstepB;
    const unsigned ldsw = (unsigned)wid * 1024u;
    const int aoff = lds_byte(wr * 64 + fr, fq * 8), boff = lds_byte(wc * 32 + fr, fq * 8);
#define PG8_SA(b, h) (((b) * 2 + (h)) * HTB)
#define PG8_SB(b, h) ((4 + (b) * 2 + (h)) * HTB)
#define PG8_STAGE(bufoff, gbase, voff) do { _Pragma("unroll") for (int _i = 0; _i < 2; ++_i) \
        __builtin_amdgcn_global_load_lds((const unsigned*)((const char*)(gbase) + (voff)[_i]), (LAS unsigned*)(lds + (bufoff) + ldsw + _i * 8192), 16, 0, 0); } while (0)
#define PG8_LDA(dst, b, h) do { _Pragma("unroll") for (int m = 0; m < 4; ++m) _Pragma("unroll") for (int k = 0; k < 2; ++k) dst[m][k] = *(const LAS bf16x8*)(lds + PG8_SA(b, h) + aoff + m * 2048 + k * 1024); } while (0)
#define PG8_LDB(dst, b, h) do { _Pragma("unroll") for (int n = 0; n < 2; ++n) _Pragma("unroll") for (int k = 0; k < 2; ++k) dst[n][k] = *(const LAS bf16x8*)(lds + PG8_SB(b, h) + boff + n * 2048 + k * 1024); } while (0)
#define PG8_MMA(ai, bj, At, Bt) do { __builtin_amdgcn_s_setprio(2); _Pragma("unroll") for (int m = 0; m < 4; ++m) _Pragma("unroll") for (int n = 0; n < 2; ++n) _Pragma("unroll") for (int k = 0; k < 2; ++k) \
        acc[ai][bj][m][n] = __builtin_amdgcn_mfma_f32_16x16x32_bf16(Bt[n][k], At[m][k], acc[ai][bj][m][n], 0, 0, 0); __builtin_amdgcn_s_setprio(0); } while (0)
#define PG8_WAIT_V(n) asm volatile("s_waitcnt vmcnt(" #n ")" ::: "memory")
#define PG8_WAIT_L(n) asm volatile("s_waitcnt lgkmcnt(" #n ")" ::: "memory")
#define PG8_BAR __builtin_amdgcn_s_barrier()
#define PG8_SCHED __builtin_amdgcn_sched_barrier(0)
    Unit cur, nxt; int ui = 0;
    if (!S.next(0, cur)) return;
    f32x4 acc[2][2][4][2];
#pragma unroll
    for (int a = 0; a < 2; ++a)
#pragma unroll
        for (int b = 0; b < 2; ++b)
#pragma unroll
            for (int m = 0; m < 4; ++m)
#pragma unroll
                for (int n = 0; n < 2; ++n) acc[a][b][m][n] = (f32x4){0.f, 0.f, 0.f, 0.f};
    bf16x8 At[4][2], B0[2][2], B1[2][2];
    const char* cA = (const char*)g.A + (size_t)cur.pm * tstepA; const char* cB = (const char*)g.Bt + (size_t)cur.pn * tstepB;
#define PG8_ROWTBL(uidx, unit) do { if constexpr (Epi::ROWTBL) { if (wid < 4) __builtin_amdgcn_global_load_lds((const unsigned*)(E.rowtbl_src() + (unit).pm * 256 + wid * 64 + lane), \
        (LAS unsigned*)(lds + LDS_ROWTBL + ((uidx) & 1) * 1024 + wid * 256), 4, 0, 0); } } while (0)
    PG8_ROWTBL(0, cur);
    PG8_STAGE(PG8_SB(0, 0), cB, voffB); PG8_STAGE(PG8_SB(0, 1), cB + hstepB, voffB); PG8_STAGE(PG8_SA(0, 0), cA, voffA); PG8_STAGE(PG8_SA(0, 1), cA + hstepA, voffA);
    if (wr == 1) PG8_BAR;
    PG8_WAIT_V(2); PG8_BAR;
    PG8_STAGE(PG8_SB(1, 0), cB + kstep, voffB); PG8_STAGE(PG8_SA(1, 0), cA + kstepA, voffA); PG8_STAGE(PG8_SB(1, 1), cB + hstepB + kstep, voffB);
    PG8_WAIT_V(6); PG8_BAR;
    for (;;) {
        const bool has_next = S.next(ui + 1, nxt);
        const char* nA = has_next ? (const char*)g.A + (size_t)nxt.pm * tstepA : cA; const char* nB = has_next ? (const char*)g.Bt + (size_t)nxt.pn * tstepB : cB;
        for (int t = 0; t < nt; t += 2) {
            const bool last = (t == nt - 2);
            const char* a1 = cA + (size_t)(t + 1) * kstepA;
            const char* a2 = last ? nA : cA + (size_t)(t + 2) * kstepA; const char* b2 = last ? nB : cB + (size_t)(t + 2) * kstep;
            const char* a3 = a2 + kstepA; const char* b3 = b2 + kstep;
            PG8_LDB(B0, 0, 0); PG8_LDB(B1, 0, 1); PG8_SCHED; PG8_LDA(At, 0, 0); PG8_STAGE(PG8_SA(1, 1), a1 + hstepA, voffA);
            PG8_WAIT_V(8); PG8_WAIT_L(0); PG8_BAR; PG8_MMA(0, 0, At, B0); PG8_MMA(0, 1, At, B1); PG8_BAR; PG8_SCHED;
            PG8_LDA(At, 0, 1); PG8_STAGE(PG8_SB(0, 0), b2, voffB); PG8_STAGE(PG8_SB(0, 1), b2 + hstepB, voffB); PG8_STAGE(PG8_SA(0, 0), a2, voffA);
            PG8_WAIT_V(8); PG8_WAIT_L(0); PG8_BAR; PG8_MMA(1, 0, At, B0); PG8_MMA(1, 1, At, B1); PG8_BAR; PG8_SCHED;
            PG8_LDB(B0, 1, 0); PG8_LDB(B1, 1, 1); PG8_SCHED; PG8_LDA(At, 1, 0); PG8_STAGE(PG8_SA(0, 1), a2 + hstepA, voffA);
            PG8_WAIT_V(8); PG8_WAIT_L(0); PG8_BAR; PG8_MMA(0, 0, At, B0); PG8_MMA(0, 1, At, B1); PG8_BAR; PG8_SCHED;
            PG8_LDA(At, 1, 1); PG8_STAGE(PG8_SB(1, 0), b3, voffB); PG8_STAGE(PG8_SB(1, 1), b3 + hstepB, voffB); PG8_STAGE(PG8_SA(1, 0), a3, voffA);
            PG8_WAIT_V(8); PG8_WAIT_L(0); PG8_BAR; PG8_MMA(1, 0, At, B0); PG8_MMA(1, 1, At, B1); PG8_BAR; PG8_SCHED;
        }
        if (wr == 0) PG8_BAR;
        E(acc, cur, wr, wc, fr, fq, (const LAS float*)(lds + LDS_ROWTBL + (ui & 1) * 1024));
        if (!has_next) break;
#pragma unroll
        for (int a = 0; a < 2; ++a)
#pragma unroll
            for (int b = 0; b < 2; ++b)
#pragma unroll
                for (int m = 0; m < 4; ++m)
#pragma unroll
                    for (int n = 0; n < 2; ++n) acc[a][b][m][n] = (f32x4){0.f, 0.f, 0.f, 0.f};
        cur = nxt; cA = nA; cB = nB; ++ui;
        PG8_ROWTBL(ui, cur);
        if (wr == 1) PG8_BAR;
    }
    PG8_WAIT_V(0);
    PG8_BAR;
#undef PG8_ROWTBL
#undef PG8_SA
#undef PG8_SB
#undef PG8_STAGE
#undef PG8_LDA
#undef PG8_LDB
#undef PG8_MMA
#undef PG8_WAIT_V
#undef PG8_WAIT_L
#undef PG8_BAR
#undef PG8_SCHED
}
}
using pg8::Unit;

struct Params {
    const float* in[26];
    float* out;
    unsigned char* ws;
};

__device__ __forceinline__ float* hrow(float* out, float* hmeta, int row) { return row < MR ? out + (size_t)row * DM : hmeta + (size_t)(row - MR) * DM; }

constexpr int ACT_KT = FF / 64;
__device__ __forceinline__ size_t act_off(int row, int j) { return ((((size_t)(row >> 8) * ACT_KT + (j >> 6)) * 256 + (row & 255)) << 6) + (j & 63); }
__device__ __forceinline__ void load_rs8(float (&rs)[8], const float* ssq, int pm, int wr, int fr) {
#pragma unroll
    for (int ai = 0; ai < 2; ++ai)
#pragma unroll
        for (int m = 0; m < 4; ++m) rs[ai * 4 + m] = ssq[pm * 256 + ai * 128 + wr * 64 + m * 16 + fr];
#pragma unroll
    for (int i = 0; i < 8; ++i) rs[i] = __builtin_amdgcn_rsqf(rs[i] * (1.0f / DM) + EPS);
}
struct EpiSwiglu {
    bf16_t* act; const float* ssq;
    static constexpr bool ROWTBL = true; __device__ __forceinline__ const float* rowtbl_src() const { return ssq; }
    __device__ __forceinline__ void operator()(const f32x4 (&acc)[2][2][4][2], const Unit& u, int wr, int wc, int fr, int fq, const LAS float* tbl) const {
        const int col0 = u.pn * 128 + wc * 32 + 8 * fq;
        float rs8[8];
#pragma unroll
        for (int i = 0; i < 8; ++i) rs8[i] = __builtin_amdgcn_rsqf(tbl[(i >> 2) * 128 + wr * 64 + (i & 3) * 16 + fr] * (1.0f / DM) + EPS);
#pragma unroll
        for (int ai = 0; ai < 2; ++ai)
#pragma unroll
            for (int m = 0; m < 4; ++m) {
                const int row = u.pm * 256 + ai * 128 + wr * 64 + m * 16 + fr;
                const float rs = rs8[ai * 4 + m], nk = -1.4426950408889634f * rs, r2 = rs * rs;
                f32x4 o[2];
#pragma unroll
                for (int n = 0; n < 2; ++n) {
                    const f32x4 a = acc[ai][0][m][n], b = acc[ai][1][m][n];
                    const f32x4 t = a * nk; f32x4 ex;
#pragma unroll
                    for (int e = 0; e < 4; ++e) ex[e] = __builtin_amdgcn_exp2f(t[e]);
                    const f32x4 dn = ex + 1.0f; f32x4 sg;
#pragma unroll
                    for (int e = 0; e < 4; ++e) sg[e] = __builtin_amdgcn_rcpf(dn[e]);
                    o[n] = ((a * b) * r2) * sg;
                }
                __builtin_nontemporal_store(pack8(o[0], o[1]), (u32x4*)(act + act_off(row, col0)));
            }
    }
};

__device__ __forceinline__ void unpack8(u32x4 w, f32x4& a, f32x4& b) {
    a[0] = __uint_as_float(w.x << 16); a[1] = __uint_as_float(w.x & 0xffff0000u); a[2] = __uint_as_float(w.y << 16); a[3] = __uint_as_float(w.y & 0xffff0000u);
    b[0] = __uint_as_float(w.z << 16); b[1] = __uint_as_float(w.z & 0xffff0000u); b[2] = __uint_as_float(w.w << 16); b[3] = __uint_as_float(w.w & 0xffff0000u);
}
template <int MODE  > struct EpiRes {
    const float* x; const float* meta; float* out; bf16_t* hb; float* ssq_out; float coef;
    static constexpr bool ROWTBL = false;
    __device__ __forceinline__ void operator()(const f32x4 (&acc)[2][2][4][2], const Unit& u, int wr, int wc, int fr, int fq, const LAS float* tbl) const {
        const int col0 = u.pn * 256 + wc * 32 + 8 * fq;
#pragma unroll
        for (int ai = 0; ai < 2; ++ai)
#pragma unroll
            for (int m = 0; m < 4; ++m) {
                const int row = u.pm * 256 + ai * 128 + wr * 64 + m * 16 + fr;
                const float* src = nullptr;
                if (MODE == 0) { if (row < MR) src = x + (size_t)row * DM; else if (row < MR + NMETA) src = meta + (size_t)(row - MR) * DM; }
                bf16_t* hrow_ = hb + (size_t)row * DM + col0;
                float ss = 0.f;
#pragma unroll
                for (int bj = 0; bj < 2; ++bj) {
                    f32x4 r0 = (f32x4){0.f, 0.f, 0.f, 0.f}, r1 = r0;
                    if (MODE == 0) { if (src) { r0 = *(const f32x4*)(src + col0 + bj * 128); r1 = *(const f32x4*)(src + col0 + bj * 128 + 4); } }
                    else unpack8(*(const u32x4*)(hrow_ + bj * 128), r0, r1);
                    const f32x4 v0 = r0 + acc[ai][bj][m][0] * coef, v1 = r1 + acc[ai][bj][m][1] * coef;
                    if (MODE == 2) { float* op = out + (size_t)row * DM + col0 + bj * 128; __builtin_nontemporal_store(v0, (f32x4*)op); __builtin_nontemporal_store(v1, (f32x4*)(op + 4)); }
                    else {
                        *(u32x4*)(hrow_ + bj * 128) = pack8(v0, v1);
                        ss += v0[0] * v0[0] + v0[1] * v0[1] + v0[2] * v0[2] + v0[3] * v0[3] + v1[0] * v1[0] + v1[1] * v1[1] + v1[2] * v1[2] + v1[3] * v1[3];
                    }
                }
                if (MODE != 2) { ss += __shfl_xor(ss, 16); ss += __shfl_xor(ss, 32); if (fq == 0) unsafeAtomicAdd(ssq_out + row, ss); }
            }
    }
};

struct EpiGlu {
    bf16_t* hb; float* ssq_out;
    static constexpr bool ROWTBL = false;
    __device__ __forceinline__ void operator()(const f32x4 (&acc)[2][2][4][2], const Unit& u, int wr, int wc, int fr, int fq, const LAS float* tbl) const {
        const int col0 = u.pn * 128 + wc * 32 + 8 * fq;
#pragma unroll
        for (int ai = 0; ai < 2; ++ai)
#pragma unroll
            for (int m = 0; m < 4; ++m) {
                const int row = u.pm * 256 + ai * 128 + wr * 64 + m * 16 + fr;
                bf16_t* hp = hb + (size_t)row * DM + col0;
                f32x4 v[2]; unpack8(*(const u32x4*)hp, v[0], v[1]);
                float ss = 0.f;
#pragma unroll
                for (int n = 0; n < 2; ++n) {
                    const f32x4 t = acc[ai][1][m][n] * (-1.4426950408889634f); f32x4 ex;
#pragma unroll
                    for (int e = 0; e < 4; ++e) ex[e] = __builtin_amdgcn_exp2f(t[e]);
                    const f32x4 dn = ex + 1.0f; f32x4 sg;
#pragma unroll
                    for (int e = 0; e < 4; ++e) sg[e] = __builtin_amdgcn_rcpf(dn[e]);
                    v[n] = v[n] + acc[ai][0][m][n] * sg;
                    const f32x4 sq = v[n] * v[n]; ss += (sq[0] + sq[1]) + (sq[2] + sq[3]);
                }
                *(u32x4*)hp = pack8(v[0], v[1]);
                ss += __shfl_xor(ss, 16); ss += __shfl_xor(ss, 32); if (fq == 0) unsafeAtomicAdd(ssq_out + row, ss);
            }
    }
};

struct EpiWin {
    bf16_t* ug; float* umeta; const float* ssq;
    static constexpr bool ROWTBL = false;
    __device__ __forceinline__ void operator()(const f32x4 (&acc)[2][2][4][2], const Unit& u, int wr, int wc, int fr, int fq, const LAS float* tbl) const {
#pragma unroll
        for (int ai = 0; ai < 2; ++ai)
#pragma unroll
            for (int m = 0; m < 4; ++m) {
                const int row = u.pm * 256 + ai * 128 + wr * 64 + m * 16 + fr;
                const float rs = __builtin_amdgcn_rsqf(ssq[row] * (1.0f / DM) + EPS);
#pragma unroll
                for (int bj = 0; bj < 2; ++bj) {
                    const int col0 = u.pn * 256 + bj * 128 + wc * 32 + 8 * fq, g = col0 >> 4, c0 = col0 & 15;
                    const f32x4 v0 = acc[ai][bj][m][0] * rs, v1 = acc[ai][bj][m][1] * rs;
                    if (row < MR) { const int chunk = row >> 6, t = row & 63; *(u32x4*)(ug + ((size_t)(g * 1024 + chunk) * KC + t * 16 + c0)) = pack8(v0, v1); }
                    else if (row < MR + NMETA) { float* p = umeta + (size_t)(row - MR) * SW + col0; *(f32x4*)p = v0; *(f32x4*)(p + 4) = v1; }
                }
            }
    }
};

struct EpiSloc {
    float* sloc;
    static constexpr bool ROWTBL = false;
    __device__ __forceinline__ void operator()(const f32x4 (&acc)[2][2][4][2], const Unit& u, int wr, int wc, int fr, int fq, const LAS float* tbl) const {
        const int g = u.pn, col0 = wc * 32 + 8 * fq;
#pragma unroll
        for (int ai = 0; ai < 2; ++ai)
#pragma unroll
            for (int m = 0; m < 4; ++m) {
                const int chunk = (u.pm & 3) * 256 + ai * 128 + wr * 64 + m * 16 + fr;
                float* p = sloc + ((size_t)(g * 1024 + chunk) * 128 + col0);
                *(f32x4*)p = acc[ai][0][m][0]; *(f32x4*)(p + 4) = acc[ai][0][m][1];
            }
    }
};

struct EpiY {
    bf16_t* yb;
    static constexpr bool ROWTBL = false;
    __device__ __forceinline__ void operator()(const f32x4 (&acc)[2][2][4][2], const Unit& u, int wr, int wc, int fr, int fq, const LAS float* tbl) const {
        const int g = u.pm >> 2;
#pragma unroll
        for (int ai = 0; ai < 2; ++ai)
#pragma unroll
            for (int m = 0; m < 4; ++m) {
                const int chunk = (u.pm & 3) * 256 + ai * 128 + wr * 64 + m * 16 + fr;
#pragma unroll
                for (int bj = 0; bj < 2; ++bj) {
                    const int cn = (u.pn & 3) * 256 + bj * 128 + wc * 32 + 8 * fq, t = cn >> 4, c0 = cn & 15;
                    f32x4 o[2];
#pragma unroll
                    for (int n = 0; n < 2; ++n) {
                        const f32x4 y = acc[ai][bj][m][n];
                        const f32x4 t = (y * (y * y * (-0.044715f * 2.302208198f) + (-2.302208198f))); f32x4 ex;
#pragma unroll
                        for (int e = 0; e < 4; ++e) ex[e] = __builtin_amdgcn_exp2f(t[e]);
                        const f32x4 dn = ex + 1.0f; f32x4 sg;
#pragma unroll
                        for (int e = 0; e < 4; ++e) sg[e] = __builtin_amdgcn_rcpf(dn[e]);
                        o[n] = y * sg;
                    }
                    *(u32x4*)(yb + ((size_t)(chunk * 64 + t) * SW + 16 * g + c0)) = pack8(o[0], o[1]);
                }
            }
    }
};

template <bool ISQ> struct EpiHead {
    bf16_t* o0; bf16_t* o1;
    const float* ssq; const float* gain; const float* rope; float scale;
    static constexpr bool ROWTBL = false;
    __device__ __forceinline__ void operator()(const f32x4 (&acc)[2][2][4][2], const Unit& u, int wr, int wc, int fr, int fq, const LAS float* tbl) const {
        const bool isv = (!ISQ) && (u.pn == 1);
        const int ld = ISQ ? DM : 256;
        const int hcol = (ISQ ? u.pn * 256 : 0) + wc * 64 + 8 * fq;
        f32x4 gn[2][2];
#pragma unroll
        for (int bj = 0; bj < 2; ++bj)
#pragma unroll
            for (int n = 0; n < 2; ++n) gn[bj][n] = *(const f32x4*)(gain + 32 * bj + 8 * fq + 4 * n);
#pragma unroll
        for (int ai = 0; ai < 2; ++ai)
#pragma unroll
            for (int m = 0; m < 4; ++m) {
                const int row = u.pm * 256 + ai * 128 + wr * 64 + m * 16 + fr;
                const float rs = __builtin_amdgcn_rsqf(ssq[row] * (1.0f / DM) + EPS);
                f32x4 v[2][2];
#pragma unroll
                for (int bj = 0; bj < 2; ++bj)
#pragma unroll
                    for (int n = 0; n < 2; ++n) v[bj][n] = acc[ai][bj][m][n] * rs;
                if (isv) {
                    bf16_t* p = o1 + (size_t)row * 256 + hcol;
                    *(u32x4*)p = pack8(v[0][0], v[0][1]); *(u32x4*)(p + 32) = pack8(v[1][0], v[1][1]);
                } else {
                    float ss = 0.f;
#pragma unroll
                    for (int bj = 0; bj < 2; ++bj)
#pragma unroll
                        for (int n = 0; n < 2; ++n) ss += v[bj][n][0] * v[bj][n][0] + v[bj][n][1] * v[bj][n][1] + v[bj][n][2] * v[bj][n][2] + v[bj][n][3] * v[bj][n][3];
                    ss += __shfl_xor(ss, 16); ss += __shfl_xor(ss, 32);
                    const float rk = __builtin_amdgcn_rsqf(ss * (1.0f / HD) + EPS) * scale;
                    const int pos = row < MR ? NMETA + (row & (SEQ - 1)) : ((row - MR) & 15);
                    const float* rp = rope + ((size_t)pos * 32 + 8 * fq) * 2;
                    f32x4 o[2][2];
#pragma unroll
                    for (int n = 0; n < 2; ++n) {
                        const f32x4 cs0 = *(const f32x4*)(rp + 8 * n), cs1 = *(const f32x4*)(rp + 8 * n + 4);
                        const f32x4 x1 = v[0][n] * gn[0][n] * rk, x2 = v[1][n] * gn[1][n] * rk;
                        o[0][n][0] = x1[0] * cs0[0] - x2[0] * cs0[1]; o[1][n][0] = x2[0] * cs0[0] + x1[0] * cs0[1];
                        o[0][n][1] = x1[1] * cs0[2] - x2[1] * cs0[3]; o[1][n][1] = x2[1] * cs0[2] + x1[1] * cs0[3];
                        o[0][n][2] = x1[2] * cs1[0] - x2[2] * cs1[1]; o[1][n][2] = x2[2] * cs1[0] + x1[2] * cs1[1];
                        o[0][n][3] = x1[3] * cs1[2] - x2[3] * cs1[3]; o[1][n][3] = x2[3] * cs1[2] + x1[3] * cs1[3];
                    }
                    bf16_t* p = o0 + (size_t)row * ld + hcol;
                    *(u32x4*)p = pack8(o[0][0], o[0][1]); *(u32x4*)(p + 32) = pack8(o[1][0], o[1][1]);
                }
            }
    }
};


template <int NT, int KS, bool ACT_TILED = false>
__device__ __forceinline__ void skinny_acc(f32x4 (&acc)[NT], LAS unsigned char* lds, const bf16_t* A, int lda, const bf16_t* Bt, int ldb, const int (&noff)[NT], int lane, int wave) {
    const int fr = lane & 15, fq = lane >> 4;
    const bf16_t* ap = A + (size_t)fr * lda + 8 * fq + 32 * KS * wave;
    bf16x8 a[KS], b[NT][KS];
#pragma unroll
    for (int k = 0; k < KS; ++k) a[k] = ACT_TILED ? *(const bf16x8*)(A + act_off(MR + fr, 32 * (KS * wave + k) + 8 * fq)) : *(const bf16x8*)(ap + 32 * k);
#pragma unroll
    for (int t = 0; t < NT; ++t) { const bf16_t* bp = Bt + (size_t)(noff[t] + fr) * ldb + 8 * fq + 32 * KS * wave;
#pragma unroll
        for (int k = 0; k < KS; ++k) b[t][k] = *(const bf16x8*)(bp + 32 * k); }
#pragma unroll
    for (int t = 0; t < NT; ++t) { acc[t] = (f32x4){0.f, 0.f, 0.f, 0.f};
#pragma unroll
        for (int k = 0; k < KS; ++k) acc[t] = __builtin_amdgcn_mfma_f32_16x16x32_bf16(b[t][k], a[k], acc[t], 0, 0, 0); }
    LAS f32x4* red = (LAS f32x4*)lds;
    __syncthreads();
#pragma unroll
    for (int t = 0; t < NT; ++t) red[(wave * NT + t) * 64 + lane] = acc[t];
    __syncthreads();
    if (wave == 0) {
#pragma unroll
        for (int t = 0; t < NT; ++t) { f32x4 s = red[t * 64 + lane];
#pragma unroll
            for (int w = 1; w < 8; ++w) s += red[(w * NT + t) * 64 + lane];
            acc[t] = s; }
    }
    __syncthreads();
}
__device__ __forceinline__ u32x2 pack4(f32x4 a) { u32x2 w; w.x = cvt_pk_bf16(a[0], a[1]); w.y = cvt_pk_bf16(a[2], a[3]); return w; }
__device__ __forceinline__ f32x4 unpack4(u32x2 w) { f32x4 a; a[0] = __uint_as_float(w.x << 16); a[1] = __uint_as_float(w.x & 0xffff0000u); a[2] = __uint_as_float(w.y << 16); a[3] = __uint_as_float(w.y & 0xffff0000u); return a; }

__device__ __forceinline__ void sk_swiglu(int item, const bf16_t* HB, const bf16_t* W, bf16_t* ACT, const float* ssq, int lane, int wave, LAS unsigned char* lds) {
    const int fr = lane & 15, fq = lane >> 4, j0 = 16 * item, pn = j0 >> 7, jj = j0 & 127;
    const int noff[2] = {256 * pn + jj, 256 * pn + 128 + jj};
    f32x4 acc[2]; skinny_acc<2, 4>(acc, lds, HB + (size_t)MR * DM, DM, W, DM, noff, lane, wave);
    if (wave == 0) {
    const float rs = __builtin_amdgcn_rsqf(ssq[MR + fr] * (1.0f / DM) + EPS);
    f32x4 o;
#pragma unroll
    for (int i = 0; i < 4; ++i) { const float a = acc[0][i] * rs, b = acc[1][i] * rs; o[i] = a * fast_sigmoid(a) * b; }
    *(u32x2*)(ACT + act_off(MR + fr, j0 + 4 * fq)) = pack4(o);
    }
}
__device__ __forceinline__ void sk_down(int item, const bf16_t* ACT, const bf16_t* W, bf16_t* HB, const float* meta  , float* ssq_out, int lane, int wave, LAS unsigned char* lds) {
    const int fr = lane & 15, fq = lane >> 4, c0 = 16 * item + 4 * fq;
    const int noff[1] = {16 * item};
    f32x4 acc[1]; skinny_acc<1, 11, true>(acc, lds, ACT, FF, W, FF, noff, lane, wave);
    if (wave == 0) {
    bf16_t* hp = HB + (size_t)(MR + fr) * DM + c0;
    const f32x4 r = meta ? *(const f32x4*)(meta + (size_t)fr * DM + c0) : unpack4(*(const u32x2*)hp);
    const f32x4 v = r + acc[0] * 0.5f;
    *(u32x2*)hp = pack4(v);
    float ss = v[0] * v[0] + v[1] * v[1] + v[2] * v[2] + v[3] * v[3];
    ss += __shfl_xor(ss, 16); ss += __shfl_xor(ss, 32); if (fq == 0) unsafeAtomicAdd(ssq_out + MR + fr, ss);
    }
}
__device__ __forceinline__ void sk_win(int item, const bf16_t* HB, const bf16_t* W, float* umeta, const float* ssq, int lane, int wave, LAS unsigned char* lds) {
    const int fr = lane & 15, fq = lane >> 4;
    const int noff[1] = {16 * item};
    f32x4 acc[1]; skinny_acc<1, 4>(acc, lds, HB + (size_t)MR * DM, DM, W, DM, noff, lane, wave);
    if (wave == 0) {
    const float rs = __builtin_amdgcn_rsqf(ssq[MR + fr] * (1.0f / DM) + EPS);
    *(f32x4*)(umeta + (size_t)fr * SW + 16 * item + 4 * fq) = acc[0] * rs;
    }
}
__device__ __forceinline__ void sk_glu(int item, const bf16_t* YB, const bf16_t* W, bf16_t* HB, float* ssq_out, int lane, int wave, LAS unsigned char* lds) {
    const int fr = lane & 15, fq = lane >> 4, j0 = 16 * item, pn = j0 >> 7, jj = j0 & 127;
    const int noff[2] = {256 * pn + jj, 256 * pn + 128 + jj};
    f32x4 acc[2]; skinny_acc<2, 2>(acc, lds, YB + (size_t)MR * SW, SW, W, SW, noff, lane, wave);
    if (wave == 0) {
    bf16_t* hp = HB + (size_t)(MR + fr) * DM + j0 + 4 * fq;
    f32x4 v = unpack4(*(const u32x2*)hp);
    float ss = 0.f;
#pragma unroll
    for (int i = 0; i < 4; ++i) { v[i] += acc[0][i] * fast_sigmoid(acc[1][i]); ss += v[i] * v[i]; }
    *(u32x2*)hp = pack4(v);
    ss += __shfl_xor(ss, 16); ss += __shfl_xor(ss, 32); if (fq == 0) unsafeAtomicAdd(ssq_out + MR + fr, ss);
    }
}
__device__ __forceinline__ void sk_kv(int item, const bf16_t* HB, const bf16_t* W, bf16_t* KB, bf16_t* VB, const float* ssq, const float* gain, const float* rope, int lane, int wave, LAS unsigned char* lds) {
    const int fr = lane & 15, fq = lane >> 4, kv = item >> 2, wc = item & 3;
    const int noff[4] = {256 * kv + 32 * wc, 256 * kv + 32 * wc + 16, 256 * kv + 128 + 32 * wc, 256 * kv + 128 + 32 * wc + 16};
    f32x4 acc[4]; skinny_acc<4, 4>(acc, lds, HB + (size_t)MR * DM, DM, W, DM, noff, lane, wave);
    if (wave == 0) {
    const float rs = __builtin_amdgcn_rsqf(ssq[MR + fr] * (1.0f / DM) + EPS);
    f32x4 v[4];
#pragma unroll
    for (int t = 0; t < 4; ++t) v[t] = acc[t] * rs;
    if (kv == 1) {
#pragma unroll
        for (int t = 0; t < 4; ++t) *(u32x2*)(VB + (size_t)(MR + fr) * 256 + wc * 64 + 16 * t + 4 * fq) = pack4(v[t]);
    } else {
        float ss = 0.f;
#pragma unroll
        for (int t = 0; t < 4; ++t) ss += v[t][0] * v[t][0] + v[t][1] * v[t][1] + v[t][2] * v[t][2] + v[t][3] * v[t][3];
        ss += __shfl_xor(ss, 16); ss += __shfl_xor(ss, 32);
        const float rk = __builtin_amdgcn_rsqf(ss * (1.0f / HD) + EPS);
        f32x4 o[4];
#pragma unroll
        for (int t = 0; t < 2; ++t) {
            const int d0 = 16 * t + 4 * fq;
            const f32x4 g1 = *(const f32x4*)(gain + d0), g2 = *(const f32x4*)(gain + 32 + d0);
            const float* rp = rope + ((size_t)fr * 32 + d0) * 2;
            const f32x4 cs0 = *(const f32x4*)rp, cs1 = *(const f32x4*)(rp + 4);
            const f32x4 x1 = v[t] * g1 * rk, x2 = v[t + 2] * g2 * rk;
            o[t][0] = x1[0] * cs0[0] - x2[0] * cs0[1]; o[t + 2][0] = x2[0] * cs0[0] + x1[0] * cs0[1];
            o[t][1] = x1[1] * cs0[2] - x2[1] * cs0[3]; o[t + 2][1] = x2[1] * cs0[2] + x1[1] * cs0[3];
            o[t][2] = x1[2] * cs1[0] - x2[2] * cs1[1]; o[t + 2][2] = x2[2] * cs1[0] + x1[2] * cs1[1];
            o[t][3] = x1[3] * cs1[2] - x2[3] * cs1[3]; o[t + 2][3] = x2[3] * cs1[2] + x1[3] * cs1[3];
        }
#pragma unroll
        for (int t = 0; t < 4; ++t) *(u32x2*)(KB + (size_t)(MR + fr) * 256 + wc * 64 + 16 * t + 4 * fq) = pack4(o[t]);
    }
    }
}

__device__ __forceinline__ int src_col(int n, int mode) {
    const int tb = n >> 8, r = n & 255;
    if (mode == 1) return (r < 128) ? tb * 128 + r : FF + tb * 128 + (r - 128);
    if (mode == 2) return (r < 128) ? tb * 128 + r : DM + tb * 128 + (r - 128);
    if (mode == 3) { const int bj = r >> 7, wc = (r >> 5) & 3, i = r & 31; return tb * 256 + 64 * wc + 32 * bj + i; }
    return n;
}
__device__ __forceinline__ void conv_wT(LAS float* scr, const float* W, int K, int Nsrc, const float* gain, bf16_t* Bt, int Ndst, int mode, int G, int wg) {
    const int tid = threadIdx.x, nkt = K / 64, ntiles = (Ndst / 128) * nkt;
    const int kk = tid >> 5, j4 = tid & 31, nn = tid >> 2, q = tid & 3;
    f32x4 v[4]; float gk[4];
    int tl = wg;
    if (tl < ntiles) {
        const int n0 = (tl / nkt) * 128, k0 = (tl % nkt) * 64, sc = src_col(n0 + (j4 >> 3) * 32, mode) + ((4 * j4) & 31);
#pragma unroll
        for (int s = 0; s < 4; ++s) { v[s] = __builtin_nontemporal_load((const f32x4*)(W + (size_t)(k0 + kk + 16 * s) * Nsrc + sc)); gk[s] = gain ? gain[k0 + kk + 16 * s] : 1.f; }
    }
    for (; tl < ntiles; tl += G) {
        const int n0 = (tl / nkt) * 128, k0 = (tl % nkt) * 64;
#pragma unroll
        for (int s = 0; s < 4; ++s) { const int k = kk + 16 * s;
            scr[k * 129 + 4 * j4] = v[s][0] * gk[s]; scr[k * 129 + 4 * j4 + 1] = v[s][1] * gk[s]; scr[k * 129 + 4 * j4 + 2] = v[s][2] * gk[s]; scr[k * 129 + 4 * j4 + 3] = v[s][3] * gk[s]; }
        __syncthreads();
        const int tn = tl + G;
        if (tn < ntiles) {
            const int n1 = (tn / nkt) * 128, k1 = (tn % nkt) * 64, sc = src_col(n1 + (j4 >> 3) * 32, mode) + ((4 * j4) & 31);
#pragma unroll
            for (int s = 0; s < 4; ++s) { v[s] = __builtin_nontemporal_load((const f32x4*)(W + (size_t)(k1 + kk + 16 * s) * Nsrc + sc)); gk[s] = gain ? gain[k1 + kk + 16 * s] : 1.f; }
        }
        { f32x4 a, b, c, d;
#pragma unroll
          for (int e = 0; e < 4; ++e) { a[e] = scr[(16 * q + e) * 129 + nn]; b[e] = scr[(16 * q + 4 + e) * 129 + nn]; c[e] = scr[(16 * q + 8 + e) * 129 + nn]; d[e] = scr[(16 * q + 12 + e) * 129 + nn]; }
          bf16_t* dst = Bt + (size_t)(n0 + nn) * K + k0 + 16 * q;
          *(u32x4*)dst = pack8(a, b); *(u32x4*)(dst + 8) = pack8(c, d); }
        __syncthreads();
    }
}


typedef float f32x16 __attribute__((ext_vector_type(16)));
typedef short s16x4 __attribute__((ext_vector_type(4)));
typedef short v4i16_t __attribute__((ext_vector_type(4)));
typedef __bf16 bf16x2_t __attribute__((ext_vector_type(2)));
__device__ __forceinline__ unsigned cvtpk_s(float lo, float hi) { f32x2 v = {lo, hi}; bf16x2_t b = __builtin_convertvector(v, bf16x2_t); return __builtin_bit_cast(unsigned, b); }
__device__ __forceinline__ s16x4 vtr(LAS unsigned char* p) { return __builtin_bit_cast(s16x4, __builtin_amdgcn_ds_read_tr16_b64_v4i16((LAS v4i16_t*)p)); }
constexpr int KVS = 144;
constexpr int AT_KB = 0, AT_VB = 256 * KVS, AT_KM = 2 * 256 * KVS, AT_VM = AT_KM + 32 * KVS, AT_END = AT_VM + 32 * KVS;
static_assert(AT_END <= LDS_STAGE, "attention LDS");


template <bool BOUNDED>
__device__ __forceinline__ void attn_tile(LAS unsigned char* kbase, LAS unsigned char* vbase, const bf16x8 (&bq)[4], const f32x16& zero16, f32x16& o0, f32x16& o1, float& m, float& l,
                                          int r, int h, int troff, bool masked  , int lo, int hi) {
    f32x16 xs;
    { const bf16x8 ka = *(const LAS bf16x8*)(kbase + r * KVS + 16 * h); xs = __builtin_amdgcn_mfma_f32_32x32x16_bf16(ka, bq[0], zero16, 0, 0, 0); }
#pragma unroll
    for (int kd = 1; kd < 4; ++kd) { const bf16x8 ka = *(const LAS bf16x8*)(kbase + r * KVS + 32 * kd + 16 * h); xs = __builtin_amdgcn_mfma_f32_32x32x16_bf16(ka, bq[kd], xs, 0, 0, 0); }
    if (masked) {
        const int k0 = 4 * h;
#pragma unroll
        for (int i = 0; i < 16; ++i) { const int kr = (i & 3) + 8 * (i >> 2) + k0; xs[i] = (kr > lo && kr <= hi) ? xs[i] : -1e30f; }
    }
    float mnl;
    if (BOUNDED) mnl = m * 1.4426950408889634f;
    else {
        float tm = fmaxf(fmaxf(fmaxf(xs[0], xs[1]), fmaxf(xs[2], xs[3])), fmaxf(fmaxf(xs[4], xs[5]), fmaxf(xs[6], xs[7])));
        tm = fmaxf(tm, fmaxf(fmaxf(fmaxf(xs[8], xs[9]), fmaxf(xs[10], xs[11])), fmaxf(fmaxf(xs[12], xs[13]), fmaxf(xs[14], xs[15]))));
        tm = fmaxf(tm, __shfl_xor(tm, 32));
        const float mn = fmaxf(m, tm);
        if (__any(mn > m)) {
            const float sc = __builtin_amdgcn_exp2f((m - mn) * 1.4426950408889634f);
            l *= sc;
#pragma unroll
            for (int i = 0; i < 16; ++i) { o0[i] *= sc; o1[i] *= sc; }
            m = mn;
        }
        mnl = m * 1.4426950408889634f;
    }
    float ps = 0.f;
#pragma unroll
    for (int i = 0; i < 16; ++i) { const float pv = __builtin_amdgcn_exp2f(xs[i] * 1.4426950408889634f - mnl); xs[i] = pv; ps += pv; }
    l += ps;
#pragma unroll
    for (int s = 0; s < 2; ++s) {
        u32x4 pw; pw.x = cvtpk_s(xs[8 * s], xs[8 * s + 1]); pw.y = cvtpk_s(xs[8 * s + 2], xs[8 * s + 3]); pw.z = cvtpk_s(xs[8 * s + 4], xs[8 * s + 5]); pw.w = cvtpk_s(xs[8 * s + 6], xs[8 * s + 7]);
        const bf16x8 pf = __builtin_bit_cast(bf16x8, pw);
#pragma unroll
        for (int db = 0; db < 2; ++db) {
            LAS unsigned char* va = vbase + troff + 16 * s * KVS + 64 * db;
            const s16x4 v0 = vtr(va), v1 = vtr(va + 8 * KVS);
            bf16x8 vf; vf[0] = v0[0]; vf[1] = v0[1]; vf[2] = v0[2]; vf[3] = v0[3]; vf[4] = v1[0]; vf[5] = v1[1]; vf[6] = v1[2]; vf[7] = v1[3];
            if (db == 0) o0 = __builtin_amdgcn_mfma_f32_32x32x16_bf16(vf, pf, o0, 0, 0, 0); else o1 = __builtin_amdgcn_mfma_f32_32x32x16_bf16(vf, pf, o1, 0, 0, 0);
        }
    }
}

__device__ __forceinline__ void attn_kv_load(u32x4 (&pre)[9], const bf16_t* KB, const bf16_t* VB, int unit, int tid) {
    const int hk = unit & 3, n = (unit >> 2) & 31, b = unit >> 7, t0 = n * 128 - 128;
#pragma unroll
    for (int j = 0; j < 8; ++j) {
        const int pc = tid + j * 512, isv = pc >> 11, q = pc & 2047, kj = q >> 3, ch = q & 7, tk = t0 + kj;
        pre[j] = (u32x4){0u, 0u, 0u, 0u};
        if (tk >= 0) pre[j] = *(const u32x4*)((isv ? VB : KB) + (size_t)(b * SEQ + tk) * 256 + hk * 64 + ch * 8);
    }
    { const int isv = tid >> 8, q = tid & 255, kj = q >> 3, ch = q & 7; pre[8] = (u32x4){0u, 0u, 0u, 0u};
      if (kj < 16) pre[8] = *(const u32x4*)((isv ? VB : KB) + (size_t)(MR + kj) * 256 + hk * 64 + ch * 8); }
}
__device__ __forceinline__ void attn_kv_store(const u32x4 (&pre)[9], LAS unsigned char* lds, int tid) {
#pragma unroll
    for (int j = 0; j < 8; ++j) { const int pc = tid + j * 512, isv = pc >> 11, q = pc & 2047, kj = q >> 3, ch = q & 7; *(LAS u32x4*)(lds + (isv ? AT_VB : AT_KB) + kj * KVS + ch * 16) = pre[j]; }
    { const int isv = tid >> 8, q = tid & 255, kj = q >> 3, ch = q & 7; *(LAS u32x4*)(lds + (isv ? AT_VM : AT_KM) + kj * KVS + ch * 16) = pre[8]; }
}

template <bool BOUNDED>
__device__ __forceinline__ void attn_units(LAS unsigned char* lds, const bf16_t* QB, const bf16_t* KB, const bf16_t* VB, bf16_t* OB, const float* sinks, float bound, int G, int wg) {
    const int tid = threadIdx.x, lane = tid & 63, wave = __builtin_amdgcn_readfirstlane(tid >> 6), r = lane & 31, h = lane >> 5;
    LAS unsigned char* Kb = lds + AT_KB; LAS unsigned char* Vb = lds + AT_VB; LAS unsigned char* Km = lds + AT_KM; LAS unsigned char* Vm = lds + AT_VM;
    const int troff = ((lane & 15) >> 2) * KVS + (16 * ((lane >> 4) & 1) + 4 * (lane & 3)) * 2 + 4 * h * KVS;
    f32x16 zero16;
#pragma unroll
    for (int i = 0; i < 16; ++i) zero16[i] = 0.f;
    constexpr int NU = NB * 32 * NKVH;
    u32x4 pre[9];
    if (wg < NU) attn_kv_load(pre, KB, VB, wg, tid);
    for (int unit = wg; unit < NU; unit += G) {
        const int hk = unit & 3, n = (unit >> 2) & 31, b = unit >> 7;
        __syncthreads();
        attn_kv_store(pre, lds, tid);
        __syncthreads();
        if (unit + G < NU) attn_kv_load(pre, KB, VB, unit + G, tid);
        const int hq = hk * 4 + (wave >> 1);
        const float sink = sinks[hq];
#pragma unroll 1
        for (int qb = 0; qb < 2; ++qb) {
            const int r0 = (wave & 1) * 64 + qb * 32;
            const size_t qrow = (size_t)b * SEQ + n * 128 + r0 + r;
            bf16x8 bq[4];
#pragma unroll
            for (int kd = 0; kd < 4; ++kd) bq[kd] = *(const bf16x8*)(QB + qrow * DM + hq * 64 + 16 * kd + 8 * h);
            f32x16 o0 = zero16, o1 = zero16;
            float m, l;
            if (BOUNDED) { m = fmaxf(bound, sink); l = (h == 0) ? __builtin_amdgcn_exp2f((sink - m) * 1.4426950408889634f) : 0.f; }
            else { m = sink; l = (h == 0) ? 1.f : 0.f; }
            const int kt_lo = (n == 0 && (r0 >> 5) < 4) ? 4 : (r0 >> 5), kt_hi = (r0 >> 5) + 4;
#pragma unroll 1
            for (int tt = kt_lo - 1; tt <= kt_hi; ++tt) {
                const bool ism = (tt == kt_lo - 1);
                LAS unsigned char* kbase = ism ? Km : Kb + tt * 32 * KVS;
                LAS unsigned char* vbase = ism ? Vm : Vb + tt * 32 * KVS;
                int lo = -1, hi = 99;
                if (ism) hi = 15; else if (tt == (r0 >> 5)) lo = r; else if (tt == kt_hi) hi = r;
                const bool masked = ism || (tt == (r0 >> 5)) || (tt == kt_hi);
                attn_tile<BOUNDED>(kbase, vbase, bq, zero16, o0, o1, m, l, r, h, troff, masked, lo, hi);
            }
            l += __shfl_xor(l, 32);
            const float il = 1.f / l;
            bf16_t* op = OB + qrow * DM + hq * 64 + 4 * h;
#pragma unroll
            for (int gi = 0; gi < 4; ++gi) {
                u32x2 w0, w1;
                w0.x = cvtpk_s(o0[4 * gi] * il, o0[4 * gi + 1] * il); w0.y = cvtpk_s(o0[4 * gi + 2] * il, o0[4 * gi + 3] * il);
                w1.x = cvtpk_s(o1[4 * gi] * il, o1[4 * gi + 1] * il); w1.y = cvtpk_s(o1[4 * gi + 2] * il, o1[4 * gi + 3] * il);
                *(u32x2*)(op + 8 * gi) = w0; *(u32x2*)(op + 32 + 8 * gi) = w1;
            }
        }
    }
    __syncthreads();
}

__device__ __forceinline__ void attn_phase(LAS unsigned char* lds, const bf16_t* QB, const bf16_t* KB, const bf16_t* VB, bf16_t* OB, const float* sinks, const float* q_gain, const float* k_gain, int G, int wg) {
    const int lane = threadIdx.x & 63;
    float gq = fabsf(q_gain[lane]), gk = fabsf(k_gain[lane]);
#pragma unroll
    for (int o = 1; o < 64; o <<= 1) { gq = fmaxf(gq, __shfl_xor(gq, o)); gk = fmaxf(gk, __shfl_xor(gk, o)); }
    const float bound = 8.0f * gq * gk * 1.03f + 0.05f;
    if (bound < 30.0f) attn_units<true>(lds, QB, KB, VB, OB, sinks, bound, G, wg);
    else attn_units<false>(lds, QB, KB, VB, OB, sinks, bound, G, wg);
}

#define XB_TMO      128
#define XB_XCNT(j)  (256  + 64 * (j))
#define XB_XSUB(j)  (1280 + 64 * (j))
#define XB_XGEN(j)  (2304 + 64 * (j))
#define XB_TOP      3328
#define XB_TOPGEN   3392
#define XCD_BAR_WORDS 3456
#define XB_SPIN_CAP (1u << 18)

__device__ __forceinline__ unsigned xb_ld(unsigned* p)              { return __hip_atomic_load(p, __ATOMIC_RELAXED, __HIP_MEMORY_SCOPE_AGENT); }
__device__ __forceinline__ unsigned xb_add(unsigned* p, unsigned v) { return __hip_atomic_fetch_add(p, v, __ATOMIC_RELAXED, __HIP_MEMORY_SCOPE_AGENT); }
__device__ __forceinline__ unsigned xb_xcc_id() { return (unsigned)__builtin_amdgcn_s_getreg((3 << 11) | 20) & 0xFu; }
#define XB_SPIN(cond, bar) do { unsigned _sp = 0; while (cond) { __builtin_amdgcn_s_sleep(1); \
    if ((++_sp & 255u) == 0u) { if (xb_ld(&(bar)[XB_TMO])) break; if (_sp > XB_SPIN_CAP) { atomicAdd(&(bar)[XB_TMO], 1u); break; } } } } while (0)

struct XcdBarrier {
    unsigned* bar; unsigned x;
    volatile LAS unsigned* st;
};

__device__ __forceinline__ XcdBarrier xcd_barrier_post(unsigned* bar, volatile LAS unsigned* st) {
    XcdBarrier b; b.bar = bar; b.x = xb_xcc_id(); b.st = st;
    if (threadIdx.x == 0) (void)xb_add(&bar[XB_XCNT(b.x)], 1u);
    return b;
}
__device__ __forceinline__ void xcd_barrier_complete(unsigned* bar, unsigned x, unsigned& nloc, unsigned& nx) {
    const unsigned G = gridDim.x * gridDim.y * gridDim.z;
    unsigned sum, cnt, mine, sp = 0u;
    for (;;) {
        sum = 0u; cnt = 0u; mine = 0u;
#pragma unroll
        for (unsigned j = 0; j < 16; ++j) { const unsigned c = xb_ld(&bar[XB_XCNT(j)]); sum += c; cnt += (c > 0u) ? 1u : 0u; mine = (j == x) ? c : mine; }
        if (sum == G) break;
        __builtin_amdgcn_s_sleep(1);
        if ((++sp & 255u) == 0u) { if (xb_ld(&bar[XB_TMO])) break; if (sp > XB_SPIN_CAP) { atomicAdd(&bar[XB_TMO], 1u); break; } }
    }
    nloc = mine > 0u ? mine : 1u; nx = cnt > 0u ? cnt : 1u;
}

__device__ __forceinline__ void xcd_barrier(const XcdBarrier& b) {
    asm volatile("s_waitcnt vmcnt(0)" ::: "memory");
    __syncthreads();
    if (threadIdx.x == 0) {
        unsigned* bar = b.bar;
        __builtin_amdgcn_s_waitcnt(0);
        unsigned nloc = b.st[0], nx = b.st[1];
        if (nloc == 0u) { xcd_barrier_complete(bar, b.x, nloc, nx); b.st[0] = nloc; b.st[1] = nx; }
        const unsigned old = xb_add(&bar[XB_XSUB(b.x)], 1u);
        const unsigned gen = old / nloc;
        if (old + 1u == (gen + 1u) * nloc) {
            __builtin_amdgcn_fence(__ATOMIC_RELEASE, "agent");
            asm volatile("s_waitcnt vmcnt(0)" ::: "memory");
            const unsigned og = xb_add(&bar[XB_TOP], 1u);
            const unsigned tg = og / nx;
            if (og + 1u == (tg + 1u) * nx) xb_add(&bar[XB_TOPGEN], 1u);
            else XB_SPIN(xb_ld(&bar[XB_TOPGEN]) == tg, bar);
            __builtin_amdgcn_fence(__ATOMIC_ACQUIRE, "agent");
            xb_add(&bar[XB_XGEN(b.x)], 1u);
            asm volatile("s_waitcnt vmcnt(0)" ::: "memory");
        } else {
            XB_SPIN(xb_ld(&bar[XB_XGEN(b.x)]) == gen, bar);
            __builtin_amdgcn_fence(__ATOMIC_ACQUIRE, "agent");
            asm volatile("s_waitcnt vmcnt(0)" ::: "memory");
        }
    }
    __syncthreads();
}


constexpr int NPH = 17;
struct KArgs { Params p; int ph_lo, ph_hi; };

__global__ void __launch_bounds__(512, 2) yoco_fwd(KArgs ka) {
    extern __shared__ __attribute__((aligned(16))) unsigned char lds_raw[];
    LAS unsigned char* lds = (LAS unsigned char*)lds_raw;
    cg::grid_group grid = cg::this_grid();
    const Params& p = ka.p;
    const int tid = threadIdx.x, lane = tid & 63, wave = __builtin_amdgcn_readfirstlane(tid >> 6);
    const int G = gridDim.x, wg = blockIdx.x;
    const int gtid = wg * 512 + tid, gthreads = G * 512;
    const int gwave = wg * 8 + wave, gwaves = G * 8;
    const int swave = wave * G + wg;
    unsigned char* ws = p.ws;
    volatile LAS unsigned* MISC = (volatile LAS unsigned*)(lds + LDS_STAGE + 1024);
    if (tid < 16) MISC[tid] = 0u;
    __syncthreads();
    XcdBarrier xbar = xcd_barrier_post((unsigned*)ws, MISC + 8);
    const float* x = p.in[0]; const float* meta = p.in[1];
    const float* ffn1_norm = p.in[2]; const float* ffn1_wgu = p.in[3]; const float* ffn1_wd = p.in[4];
    const float* mix_norm = p.in[5]; const float* ffn2_norm = p.in[6]; const float* ffn2_wgu = p.in[7]; const float* ffn2_wd = p.in[8];
    const float* ssm_w_in = p.in[9]; const float* lam_re = p.in[10]; const float* lam_im = p.in[11];
    const float* b_re = p.in[12]; const float* b_im = p.in[13]; const float* c_re = p.in[14]; const float* c_im = p.in[15];
    const float* log_step = p.in[16]; const float* ssm_d = p.in[17]; const float* ssm_w_out = p.in[18];
    const float* kv_norm = p.in[19]; const float* w_kv = p.in[20]; const float* k_norm = p.in[21];
    const float* attn_w_q = p.in[22]; const float* q_norm = p.in[23]; const float* sinks = p.in[24]; const float* attn_w_o = p.in[25];
    float* out = p.out;
    bf16_t* WGU = (bf16_t*)(ws + WS_WGU); bf16_t* WD = (bf16_t*)(ws + WS_WD);
    bf16_t* WIN = (bf16_t*)(ws + WS_WIN); bf16_t* WOUT = (bf16_t*)(ws + WS_WOUT); bf16_t* WKV = (bf16_t*)(ws + WS_WKV);
    bf16_t* WQ = (bf16_t*)(ws + WS_WQ); bf16_t* WO = (bf16_t*)(ws + WS_WO);
    float* ROPE = (float*)(ws + WS_ROPE); float* SSQ = (float*)(ws + WS_SSQ); float* HMETA = (float*)(ws + WS_HMETA);
    bf16_t* HB = (bf16_t*)(ws + WS_HB); bf16_t* KB = (bf16_t*)(ws + WS_KB); bf16_t* VB = (bf16_t*)(ws + WS_VB);
    bf16_t* ACT = (bf16_t*)(ws + WS_ACT); bf16_t* UG = (bf16_t*)(ws + WS_UG); bf16_t* YB = (bf16_t*)(ws + WS_YB);
    float* UMETA = (float*)(ws + WS_UMETA); float* SMETA = (float*)(ws + WS_SMETA); float* SLOC = (float*)(ws + WS_SLOC);
    bf16_t* KMAT = (bf16_t*)(ws + WS_KMAT); bf16_t* MEND = (bf16_t*)(ws + WS_MEND);
    float* KD = (float*)(ws + WS_KD); float* APOW = (float*)(ws + WS_APOW); float* BBAR = (float*)(ws + WS_BBAR);
    bf16_t* QB = (bf16_t*)(ws + WS_QB); bf16_t* OB = (bf16_t*)(ws + WS_OB);
    const size_t EGU = (size_t)2 * FF * DM, EWD = (size_t)DM * FF;

    const int lo = ka.ph_lo, hi = ka.ph_hi;
#define IN(k) (lo <= (k) && (k) < hi)
#define SEAM(k) do { if (IN(k) && IN((k) + 1)) { if (lo < 0) grid.sync(); else xcd_barrier(xbar); } } while (0)

    if (IN(0)) {
        LAS float* scr = (LAS float*)lds;
        for (int l = 0; l < 2; ++l) {
            conv_wT(scr, ffn1_wgu + l * EGU, DM, 2 * FF, ffn1_norm + l * DM, WGU + (2 * l) * EGU, 2 * FF, 1, G, wg);
            conv_wT(scr, ffn2_wgu + l * EGU, DM, 2 * FF, ffn2_norm + l * DM, WGU + (2 * l + 1) * EGU, 2 * FF, 1, G, wg);
            conv_wT(scr, ffn1_wd + l * EWD, FF, DM, nullptr, WD + (2 * l) * EWD, DM, 0, G, wg);
            conv_wT(scr, ffn2_wd + l * EWD, FF, DM, nullptr, WD + (2 * l + 1) * EWD, DM, 0, G, wg);
        }
        conv_wT(scr, ssm_w_in, DM, SW, mix_norm, WIN, SW, 0, G, wg);
        conv_wT(scr, ssm_w_out, SW, 2 * DM, nullptr, WOUT, 2 * DM, 2, G, wg);
        conv_wT(scr, w_kv, DM, 512, kv_norm, WKV, 512, 3, G, wg);
        conv_wT(scr, attn_w_q, DM, DM, mix_norm + DM, WQ, DM, 3, G, wg);
        conv_wT(scr, attn_w_o, DM, DM, nullptr, WO, DM, 0, G, wg);
        for (int i = gtid; i < LSEQ * 32; i += gthreads) {
            const int pos = i >> 5, d = i & 31;
            const double fr = exp(-(double)d * (2.0 / HD) * 9.210340371976184);
            const double ang = (double)pos * fr;
            ROPE[2 * i] = (float)cos(ang); ROPE[2 * i + 1] = (float)sin(ang);
        }
        for (int item = wg; item < SG * 65; item += G) {
            const int g = item / 65, d = item % 65;
            LAS float* apd = (LAS float*)lds;
            LAS float* bbl = apd + 128;
            __syncthreads();
            if (tid < 64) {
                const float lr = lam_re[g * SP + tid], li = lam_im[g * SP + tid], st = expf(log_step[g]);
                const float mg = expf((float)d * lr * st), ang = (float)d * (li * st);
                const float pr = mg * cosf(ang), pi = mg * sinf(ang);
                apd[2 * tid] = pr; apd[2 * tid + 1] = pi;
                APOW[((size_t)(g * 65 + d) * 64 + tid) * 2] = pr; APOW[((size_t)(g * 65 + d) * 64 + tid) * 2 + 1] = pi;
            }
            for (int e = tid; e < 1024; e += 512) {
                const int pp = e >> 4;
                const float lr = lam_re[g * SP + pp], li = lam_im[g * SP + pp], st = expf(log_step[g]);
                const float mg = expf(lr * st), ar = mg * cosf(li * st), ai = mg * sinf(li * st);
                const float den = lr * lr + li * li, nr = ar - 1.0f, ni = ai;
                const float cr = (nr * lr + ni * li) / den, ci = (ni * lr - nr * li) / den;
                const float br = b_re[(size_t)g * 1024 + e], bi = b_im[(size_t)g * 1024 + e];
                const float vr = cr * br - ci * bi, vi = cr * bi + ci * br;
                bbl[2 * e] = vr; bbl[2 * e + 1] = vi;
                if (d == 0) { BBAR[((size_t)g * 1024 + e) * 2] = vr; BBAR[((size_t)g * 1024 + e) * 2 + 1] = vi; }
            }
            __syncthreads();
            if (d < 64 && tid < 256) {
                const int cp = tid >> 4, c = tid & 15;
                float s = 0.f;
                for (int pp = 0; pp < 64; ++pp) {
                    const float Cr = c_re[(g * SC + cp) * SP + pp], Ci = c_im[(g * SC + cp) * SP + pp];
                    const float pr = apd[2 * pp], pi = apd[2 * pp + 1];
                    const float wr_ = Cr * pr - Ci * pi, wi_ = Cr * pi + Ci * pr;
                    s += wr_ * bbl[2 * (pp * 16 + c)] - wi_ * bbl[2 * (pp * 16 + c) + 1];
                }
                if (d == 0 && c == cp) s += ssm_d[g * SC + cp];
                KD[(size_t)(g * 64 + d) * 256 + tid] = s;
            }
        }
        __syncthreads();
        for (int i = gtid; i < 5 * MT; i += gthreads) SSQ[MT + i] = 0.f;
        for (int row = gwave; row < MT; row += gwaves) {
            const float* src = row < MR ? x + (size_t)row * DM : (row < MR + NMETA ? meta + (size_t)(row - MR) * DM : nullptr);
            float ss = 0.f;
#pragma unroll
            for (int s = 0; s < 2; ++s) {
                const int c = s * 512 + lane * 8;
                f32x4 a = (f32x4){0.f, 0.f, 0.f, 0.f}, b = a;
                if (src) { a = __builtin_nontemporal_load((const f32x4*)(src + c)); b = __builtin_nontemporal_load((const f32x4*)(src + c + 4)); }
                ss += a[0] * a[0] + a[1] * a[1] + a[2] * a[2] + a[3] * a[3] + b[0] * b[0] + b[1] * b[1] + b[2] * b[2] + b[3] * b[3];
                *(u32x4*)(HB + (size_t)row * DM + c) = pack8(a, b);
            }
#pragma unroll
            for (int o = 1; o < 64; o <<= 1) ss += __shfl_xor(ss, o);
            if (lane == 0) SSQ[row] = ss;
        }
    }
    SEAM(0);
    if (IN(1)) {
        pg8::Gemm g{HB, WGU + 0 * EGU, DM, DM, DM}; pg8::StaticOrder S; S.init(MR, 2 * FF, G, wg);
        EpiSwiglu E{ACT, SSQ + 0 * MT};
        pg8::gemm_phase(lds, g, S, E);
        for (int it = wg; it < FF / 16; it += G) sk_swiglu(it, HB, WGU + 0 * EGU, ACT, SSQ + 0 * MT, lane, wave, lds);
    }
    SEAM(1);
    if (IN(2)) {
        pg8::Gemm g{ACT, WD + 0 * EWD, 64, FF, FF, 256 * 64 * 2, (long)ACT_KT * 256 * 64 * 2}; pg8::StaticOrder S; S.init(MR, DM, G, wg);
        EpiRes<0> E{x, meta, out, HB, SSQ + 1 * MT, 0.5f};
        pg8::gemm_phase(lds, g, S, E);
        for (int it = wg; it < DM / 16; it += G) sk_down(it, ACT, WD + 0 * EWD, HB, meta, SSQ + 1 * MT, lane, wave, lds);
    }
    SEAM(2);
    if (IN(3)) {
        pg8::Gemm g{HB, WIN, DM, DM, DM}; pg8::StaticOrder S; S.init(MR, SW, G, wg);
        EpiWin E{UG, UMETA, SSQ + 1 * MT};
        pg8::gemm_phase(lds, g, S, E);
        for (int it = wg; it < SW / 16; it += G) sk_win(it, HB, WIN, UMETA, SSQ + 1 * MT, lane, wave, lds);
    }
    if (IN(3)) {
        for (int it0 = gtid; it0 < SG * 1024 * 128; it0 += 4 * gthreads) {
            f32x4 v0[4], v1[4]; size_t dst[4]; bool ok[4], nz[4];
#pragma unroll
            for (int q = 0; q < 4; ++q) {
                const int it = it0 + q * gthreads; ok[q] = it < SG * 1024 * 128;
                const int itc = ok[q] ? it : 0, kq = itc & 127, n = (itc >> 7) & 1023, g = itc >> 17, t = n >> 4, cp = n & 15, k0 = kq * 8, s = k0 >> 4, c0 = k0 & 15;
                nz[q] = t >= s; const int d = nz[q] ? t - s : 0;
                const float* kp = KD + (size_t)(g * 64 + d) * 256 + cp * 16 + c0; v0[q] = *(const f32x4*)kp; v1[q] = *(const f32x4*)(kp + 4);
                dst[q] = (size_t)(g * 1024 + n) * KC + kq * 8;
            }
#pragma unroll
            for (int q = 0; q < 4; ++q) if (ok[q]) { const f32x4 z = (f32x4){0.f, 0.f, 0.f, 0.f}; *(u32x4*)(KMAT + dst[q]) = pack8(nz[q] ? v0[q] : z, nz[q] ? v1[q] : z); }
        }
        for (int it = gtid; it < SG * 1024 * 16; it += gthreads) {
            const int kq = 128 + (it & 15), n = (it >> 4) & 1023, g = it >> 14, t = n >> 4, cp = n & 15;
            f32x4 v0, v1;
            const int j0 = (kq - 128) * 8, im = j0 >> 6, p0 = j0 & 63;
#pragma unroll
            for (int e = 0; e < 8; ++e) {
                const int pp = p0 + e;
                const float Cr = c_re[(g * SC + cp) * SP + pp], Ci = c_im[(g * SC + cp) * SP + pp];
                const float pr = APOW[((size_t)(g * 65 + t + 1) * 64 + pp) * 2], pi = APOW[((size_t)(g * 65 + t + 1) * 64 + pp) * 2 + 1];
                const float val = im ? -(Cr * pi + Ci * pr) : (Cr * pr - Ci * pi);
                if (e < 4) v0[e] = val; else v1[e - 4] = val;
            }
            *(u32x4*)(KMAT + ((size_t)(g * 1024 + n) * KC + kq * 8)) = pack8(v0, v1);
        }
        for (int it = gtid; it < SG * 256 * 128; it += gthreads) {
            const int kq = it & 127, n = (it >> 7) & 255, g = it >> 15;
            f32x4 v0 = (f32x4){0.f, 0.f, 0.f, 0.f}, v1 = v0;
            if (n < 128) {
                const int im = n >> 6, pp = n & 63, k0 = kq * 8, s = k0 >> 4, c0 = k0 & 15;
                const float pr = APOW[((size_t)(g * 65 + 63 - s) * 64 + pp) * 2], pi = APOW[((size_t)(g * 65 + 63 - s) * 64 + pp) * 2 + 1];
#pragma unroll
                for (int e = 0; e < 8; ++e) {
                    const float br = BBAR[((size_t)(g * 64 + pp) * 16 + c0 + e) * 2], bi = BBAR[((size_t)(g * 64 + pp) * 16 + c0 + e) * 2 + 1];
                    const float val = im ? (pr * bi + pi * br) : (pr * br - pi * bi);
                    if (e < 4) v0[e] = val; else v1[e - 4] = val;
                }
            }
            *(u32x4*)(MEND + ((size_t)(g * 256 + n) * 1024 + kq * 8)) = pack8(v0, v1);
        }
    }
    SEAM(3);
    if (IN(4)) {
        pg8::Gemm gm{UG, MEND, KC, 1024, 1024}; pg8::BatchOrder S; S.init(SG, 4, 1, G, wg);
        EpiSloc E{SLOC};
        pg8::gemm_phase(lds, gm, S, E);
        Unit uu;
        for (int i = 0; S.next(i, uu); ++i) {
            const int g = uu.pn, pm4 = uu.pm & 3;
            LAS float* sm = (LAS float*)lds;
            __syncthreads();
            if (wave == 0) {
                const int pp = lane;
                const float ar = APOW[((size_t)(g * 65 + 1) * 64 + pp) * 2], ai = APOW[((size_t)(g * 65 + 1) * 64 + pp) * 2 + 1];
                float bbr[16], bbi[16], ccr[16], cci[16];
#pragma unroll
                for (int c = 0; c < 16; ++c) {
                    bbr[c] = BBAR[((size_t)(g * 64 + pp) * 16 + c) * 2]; bbi[c] = BBAR[((size_t)(g * 64 + pp) * 16 + c) * 2 + 1];
                    ccr[c] = c_re[(g * SC + c) * SP + pp]; cci[c] = c_im[(g * SC + c) * SP + pp];
                }
                const float dsk = ssm_d[g * SC + (lane & 15)];
                float xr = 0.f, xi = 0.f;
                for (int t = 0; t < NMETA; ++t) {
                    float uv[16];
                    const float* up = UMETA + (size_t)t * SW + g * SC;
#pragma unroll
                    for (int c = 0; c < 16; ++c) uv[c] = up[c];
                    float bur = 0.f, bui = 0.f;
#pragma unroll
                    for (int c = 0; c < 16; ++c) { bur += bbr[c] * uv[c]; bui += bbi[c] * uv[c]; }
                    const float nxr = ar * xr - ai * xi + bur, nxi = ar * xi + ai * xr + bui;
                    xr = nxr; xi = nxi;
                    if (pm4 == 0) {
                        float mine = 0.f;
#pragma unroll
                        for (int c = 0; c < 16; ++c) {
                            float z = ccr[c] * xr - cci[c] * xi;
#pragma unroll
                            for (int o = 1; o < 64; o <<= 1) z += __shfl_xor(z, o);
                            if ((lane & 15) == c) mine = z + dsk * uv[c];
                        }
                        if (lane < 16) YB[(size_t)(MR + t) * SW + g * SC + lane] = f2bf(gelu_tanh(mine));
                    }
                }
                sm[pp] = xr; sm[64 + pp] = xi;
            }
            __syncthreads();
            if (tid < 256) {
                const int pp = tid & 63, b = pm4 * 4 + (tid >> 6);
                const float ar = APOW[((size_t)(g * 65 + 64) * 64 + pp) * 2], ai = APOW[((size_t)(g * 65 + 64) * 64 + pp) * 2 + 1];
                float xr = sm[pp], xi = sm[64 + pp];
#pragma unroll 8
                for (int c = 0; c < 64; ++c) {
                    const size_t row = (size_t)g * 1024 + b * 64 + c;
                    const float sr = SLOC[row * 128 + pp], si = SLOC[row * 128 + 64 + pp];
                    UG[row * KC + 1024 + pp] = f2bf(xr); UG[row * KC + 1088 + pp] = f2bf(xi);
                    const float nxr = ar * xr - ai * xi + sr, nxi = ar * xi + ai * xr + si;
                    xr = nxr; xi = nxi;
                }
            }
        }
    }
    SEAM(5);
    if (IN(6)) {
        pg8::Gemm g{UG, KMAT, KC, KC, KC}; pg8::BatchOrder S; S.init(SG, 4, 4, G, wg);
        EpiY E{YB};
        pg8::gemm_phase(lds, g, S, E);
    }
    SEAM(6);
    if (IN(7)) {
        pg8::Gemm g{YB, WOUT, SW, SW, SW}; pg8::StaticOrder S; S.init(MR, 2 * DM, G, wg);
        EpiGlu E{HB, SSQ + 2 * MT};
        pg8::gemm_phase(lds, g, S, E);
        for (int it = wg; it < DM / 16; it += G) sk_glu(it, YB, WOUT, HB, SSQ + 2 * MT, lane, wave, lds);
    }
    SEAM(7);
    if (IN(8)) {
        pg8::Gemm g{HB, WGU + 1 * EGU, DM, DM, DM}; pg8::StaticOrder S; S.init(MR, 2 * FF, G, wg);
        EpiSwiglu E{ACT, SSQ + 2 * MT};
        pg8::gemm_phase(lds, g, S, E);
        for (int it = wg; it < FF / 16; it += G) sk_swiglu(it, HB, WGU + 1 * EGU, ACT, SSQ + 2 * MT, lane, wave, lds);
    }
    SEAM(8);
    if (IN(9)) {
        pg8::Gemm g{ACT, WD + 1 * EWD, 64, FF, FF, 256 * 64 * 2, (long)ACT_KT * 256 * 64 * 2}; pg8::StaticOrder S; S.init(MR, DM, G, wg);
        EpiRes<1> E{x, meta, out, HB, SSQ + 3 * MT, 0.5f};
        pg8::gemm_phase(lds, g, S, E);
        for (int it = wg; it < DM / 16; it += G) sk_down(it, ACT, WD + 1 * EWD, HB, nullptr, SSQ + 3 * MT, lane, wave, lds);
    }
    SEAM(9);
    if (IN(10)) {
        { pg8::Gemm g{HB, WKV, DM, DM, DM}; pg8::StaticOrder S; S.init(MR, 512, G, wg);
          EpiHead<false> E{KB, VB, SSQ + 3 * MT, k_norm, ROPE, 1.0f};
          pg8::gemm_phase(lds, g, S, E); }
        for (int it = wg; it < 8; it += G) sk_kv(it, HB, WKV, KB, VB, SSQ + 3 * MT, k_norm, ROPE, lane, wave, lds);
        __syncthreads();
        { pg8::Gemm g{HB, WGU + 2 * EGU, DM, DM, DM}; pg8::StaticOrder S; S.init(MR, 2 * FF, G, wg);
          EpiSwiglu E{ACT, SSQ + 3 * MT};
          pg8::gemm_phase(lds, g, S, E); }
    }
    SEAM(10);
    if (IN(11)) {
        pg8::Gemm g{ACT, WD + 2 * EWD, 64, FF, FF, 256 * 64 * 2, (long)ACT_KT * 256 * 64 * 2}; pg8::StaticOrder S; S.init(MR, DM, G, wg);
        EpiRes<1> E{x, meta, out, HB, SSQ + 4 * MT, 0.5f};
        pg8::gemm_phase(lds, g, S, E);
    }
    SEAM(11);
    if (IN(12)) {
        pg8::Gemm g{HB, WQ, DM, DM, DM}; pg8::StaticOrder S; S.init(MR, DM, G, wg);
        EpiHead<true> E{QB, QB, SSQ + 4 * MT, q_norm, ROPE, 0.125f};
        pg8::gemm_phase(lds, g, S, E);
    }
    SEAM(12);
    if (IN(13)) attn_phase(lds, QB, KB, VB, OB, sinks, q_norm, k_norm, G, wg);
    SEAM(13);
    if (IN(14)) {
        pg8::Gemm g{OB, WO, DM, DM, DM}; pg8::StaticOrder S; S.init(MR, DM, G, wg);
        EpiRes<1> E{x, meta, out, HB, SSQ + 5 * MT, 1.0f};
        pg8::gemm_phase(lds, g, S, E);
    }
    SEAM(14);
    if (IN(15)) {
        pg8::Gemm g{HB, WGU + 3 * EGU, DM, DM, DM}; pg8::StaticOrder S; S.init(MR, 2 * FF, G, wg);
        EpiSwiglu E{ACT, SSQ + 5 * MT};
        pg8::gemm_phase(lds, g, S, E);
    }
    SEAM(15);
    if (IN(16)) {
        pg8::Gemm g{ACT, WD + 3 * EWD, 64, FF, FF, 256 * 64 * 2, (long)ACT_KT * 256 * 64 * 2}; pg8::StaticOrder S; S.init(MR, DM, G, wg);
        EpiRes<2> E{x, meta, out, HB, SSQ, 0.5f};
        pg8::gemm_phase(lds, g, S, E);
    }
#undef IN
#undef SEAM
}

extern "C" void kernel_launch(void* const* d_in, const int* in_sizes, int n_in, void* d_out, int out_size, void* d_ws, size_t ws_size, hipStream_t stream) {
    static int grid = 0;
    if (grid == 0) {
        if (n_in != 26 || ws_size < WS_END) { fprintf(stderr, "kernel_launch: unexpected n_in %d / ws %zu (need %zu)\n", n_in, ws_size, (size_t)WS_END); grid = -1; return; }
        int dev = 0, cus = 0, per_cu = 0;
        hipGetDevice(&dev);
        hipDeviceGetAttribute(&cus, hipDeviceAttributeMultiprocessorCount, dev);
        if (hipFuncSetAttribute((const void*)yoco_fwd, hipFuncAttributeMaxDynamicSharedMemorySize, LDS_BYTES) != hipSuccess) { fprintf(stderr, "kernel_launch: hipFuncSetAttribute failed\n"); grid = -1; return; }
        hipOccupancyMaxActiveBlocksPerMultiprocessor(&per_cu, (const void*)yoco_fwd, 512, LDS_BYTES);
        if (per_cu < 1) { fprintf(stderr, "kernel_launch: occupancy query says %d blocks/CU\n", per_cu); per_cu = 1; }
        (void)hipGetLastError();
        grid = cus * 1;
    }
    if (grid < 0) return;
    KArgs ka{};
    for (int i = 0; i < 26; ++i) ka.p.in[i] = (const float*)d_in[i];
    ka.p.out = (float*)d_out; ka.p.ws = (unsigned char*)d_ws;
    ka.ph_lo = 0; ka.ph_hi = NPH;
    if (hipMemsetAsync(d_ws, 0, 65536, stream) != hipSuccess) { fprintf(stderr, "memset failed\n"); return; }
    void* args[] = {&ka};
    hipError_t e = hipLaunchCooperativeKernel((const void*)yoco_fwd, dim3(grid), dim3(512), args, LDS_BYTES, stream);
    if (e != hipSuccess) fprintf(stderr, "cooperative launch failed: %s (grid %d)\n", hipGetErrorString(e), grid);
}
```
